# Optimizing an MI355X kernel written in HIP

```python
import numpy as np
import jax, jax.numpy as jnp
from jax import lax

D_MODEL = 1024
BATCH = 16
SEQ = 4096
DEPTH = 2

N_BRANCH = 4
BRANCH_WIDTH = D_MODEL // N_BRANCH
HEAD_DIM = 64
NSA_HEADS = BRANCH_WIDTH // HEAD_DIM
NSA_CMP_LEN = 32
NSA_CMP_STRIDE = 16
NSA_CMP_HIDDEN = 2 * HEAD_DIM
NSA_SEL_LEN = 64
NSA_N_SEL = 16
NSA_WINDOW = 512
NSA_FORCE_BONUS = 1.0e4
POOL_WINDOWS = (2, 4, 8, 16)
POOL_GROUP = BRANCH_WIDTH // len(POOL_WINDOWS)
CONV_WIDTH = 3
FOX_HEADS = BRANCH_WIDTH // HEAD_DIM
ROPE_THETA = 500000.0
ROPE_DIM = HEAD_DIM // 4
Q_BLOCK = 128
NORM_EPS = 1e-6
MASK_VALUE = -1e30

IN_SPLITS = (
    NSA_HEADS * HEAD_DIM,
    6 * HEAD_DIM,
    3 * NSA_HEADS,
    BRANCH_WIDTH,
    3 * BRANCH_WIDTH,
    3 * BRANCH_WIDTH,
    FOX_HEADS,
    N_BRANCH * BRANCH_WIDTH,
    N_BRANCH * D_MODEL,
)
D_IN = sum(IN_SPLITS)

kernel_name = "hybrid_nsa_pool_conv_fox_parallel"


def rmsnorm(x, g):
    xf = x.astype(jnp.float32)
    y = xf * lax.rsqrt(jnp.mean(xf * xf, axis=-1, keepdims=True) + NORM_EPS)
    return (y * g.astype(jnp.float32)).astype(x.dtype)


def rope(x, pos):
    half = ROPE_DIM // 2
    inv = ROPE_THETA ** (-jnp.arange(half, dtype=jnp.float32) / half)
    ang = pos.astype(jnp.float32)[:, None] * inv[None, :]
    cos = jnp.cos(ang)[None, :, None, :].astype(x.dtype)
    sin = jnp.sin(ang)[None, :, None, :].astype(x.dtype)
    x1, x2, rest = x[..., :half], x[..., half:ROPE_DIM], x[..., ROPE_DIM:]
    return jnp.concatenate([x1 * cos - x2 * sin, x2 * cos + x1 * sin, rest], axis=-1)


def masked_softmax(s, mask):
    s = jnp.where(mask, s.astype(jnp.float32), MASK_VALUE)
    p = jax.nn.softmax(s, axis=-1)
    return jnp.where(mask, p, 0.0)


def to_blocks(a):
    B, T = a.shape[:2]
    a = a.reshape((B, T // Q_BLOCK, Q_BLOCK) + a.shape[2:])
    return jnp.moveaxis(a, 1, 0)


def from_blocks(a):
    a = jnp.moveaxis(a, 0, 1)
    return a.reshape((a.shape[0], a.shape[1] * a.shape[2]) + a.shape[3:])


def nsa_compress(k, pos_emb, w1, b1, w2, b2):
    B, T, hd = k.shape
    nc = (T - NSA_CMP_LEN) // NSA_CMP_STRIDE + 1
    idx = np.arange(nc)[:, None] * NSA_CMP_STRIDE + np.arange(NSA_CMP_LEN)[None, :]
    blocks = k[:, idx] + pos_emb
    flat = blocks.reshape(B, nc, NSA_CMP_LEN * hd)
    return jax.nn.silu(flat @ w1 + b1) @ w2 + b2


def nsa_mixer(q, kv, gate_logits, cmp_pos, cmp_w1, cmp_b1, cmp_w2, cmp_b2):
    B, T = q.shape[:2]
    pos = jnp.arange(T)
    q = rope(q.reshape(B, T, NSA_HEADS, HEAD_DIM), pos) * (HEAD_DIM ** -0.5)
    k_c, v_c, k_s, v_s, k_w, v_w = jnp.split(kv, 6, axis=-1)
    k_s = rope(k_s[:, :, None], pos)[:, :, 0]
    k_w = rope(k_w[:, :, None], pos)[:, :, 0]
    kc = nsa_compress(k_c, cmp_pos[0], cmp_w1[0], cmp_b1[0], cmp_w2[0], cmp_b2[0])
    vc = nsa_compress(v_c, cmp_pos[1], cmp_w1[1], cmp_b1[1], cmp_w2[1], cmp_b2[1])
    nc = kc.shape[1]
    cmp_end_np = np.arange(nc) * NSA_CMP_STRIDE + NSA_CMP_LEN - 1
    cmp_end = jnp.asarray(cmp_end_np)
    kc = rope(kc[:, :, None], cmp_end)[:, :, 0]
    n_blk = T // NSA_SEL_LEN
    n_sel = min(NSA_N_SEL, n_blk)
    ci = np.arange(nc)[:, None] * NSA_CMP_STRIDE
    sj = np.arange(n_blk)[None, :] * NSA_SEL_LEN
    overlap = jnp.asarray((ci < sj + NSA_SEL_LEN) & (ci + NSA_CMP_LEN > sj), jnp.float32)
    k_blk = k_s.reshape(B, n_blk, NSA_SEL_LEN, HEAD_DIM)
    v_blk = v_s.reshape(B, n_blk, NSA_SEL_LEN, HEAD_DIM)
    pad = ((0, 0), (NSA_WINDOW, 0), (0, 0))
    k_wp, v_wp = jnp.pad(k_w, pad), jnp.pad(v_w, pad)
    blk_ids = jnp.arange(n_blk)

    def one_block(args):
        qi, q_blk = args
        t = qi * Q_BLOCK + jnp.arange(Q_BLOCK)
        s = jnp.einsum('bqhd,bnd->bhqn', q_blk, kc)
        p_c = masked_softmax(s, (cmp_end[None, :] <= t[:, None])[None, None])
        o_cmp = jnp.einsum('bhqn,bnd->bqhd', p_c.astype(vc.dtype), vc)
        imp = jnp.einsum('bhqn,nj->bqj', p_c, overlap)
        jt = (t // NSA_SEL_LEN)[:, None]
        j = blk_ids[None, :]
        forced = (j == 0) | (j == jt) | (j == jt - 1)
        valid = j * NSA_SEL_LEN <= t[:, None]
        imp = jnp.where(valid, jnp.where(forced, imp + NSA_FORCE_BONUS, imp), MASK_VALUE)
        _, sel = lax.top_k(imp, n_sel)
        ks = jax.vmap(lambda kb, ib: kb[ib])(k_blk, sel)
        vs = jax.vmap(lambda vb, ib: vb[ib])(v_blk, sel)
        kpos = sel[..., None] * NSA_SEL_LEN + jnp.arange(NSA_SEL_LEN)
        m_s = (kpos <= t[None, :, None, None]).reshape(B, 1, Q_BLOCK, n_sel * NSA_SEL_LEN)
        s = jnp.einsum('bqhd,bqnkd->bhqnk', q_blk, ks).reshape(B, NSA_HEADS, Q_BLOCK, n_sel * NSA_SEL_LEN)
        p_s = masked_softmax(s, m_s).reshape(B, NSA_HEADS, Q_BLOCK, n_sel, NSA_SEL_LEN)
        o_slc = jnp.einsum('bhqnk,bqnkd->bqhd', p_s.astype(vs.dtype), vs)
        kw = lax.dynamic_slice_in_dim(k_wp, qi * Q_BLOCK, Q_BLOCK + NSA_WINDOW, axis=1)
        vw = lax.dynamic_slice_in_dim(v_wp, qi * Q_BLOCK, Q_BLOCK + NSA_WINDOW, axis=1)
        wpos = qi * Q_BLOCK - NSA_WINDOW + jnp.arange(Q_BLOCK + NSA_WINDOW)
        m_w = (wpos[None, :] <= t[:, None]) & (wpos[None, :] > t[:, None] - NSA_WINDOW) & (wpos[None, :] >= 0)
        s = jnp.einsum('bqhd,bkd->bhqk', q_blk, kw)
        p_w = masked_softmax(s, m_w[None, None])
        o_win = jnp.einsum('bhqk,bkd->bqhd', p_w.astype(vw.dtype), vw)
        return o_cmp, o_slc, o_win

    o_cmp, o_slc, o_win = lax.map(one_block, (jnp.arange(T // Q_BLOCK), to_blocks(q)))
    g = jax.nn.sigmoid(gate_logits.reshape(B, T, 3, NSA_HEADS))[..., None]
    o = (g[:, :, 0] * from_blocks(o_cmp) + g[:, :, 1] * from_blocks(o_slc)
         + g[:, :, 2] * from_blocks(o_win))
    return o.reshape(B, T, NSA_HEADS * HEAD_DIM)


def pool_mixer(u, pool_w, pool_scale):
    B, T, C = u.shape
    cs = jnp.concatenate([jnp.zeros((B, 1, C), jnp.float32),
                          jnp.cumsum(u.astype(jnp.float32), axis=1)], axis=1)
    outs = []
    for gi, w in enumerate(POOL_WINDOWS):
        sl = slice(gi * POOL_GROUP, (gi + 1) * POOL_GROUP)
        csg = cs[..., sl]
        lag = jnp.concatenate([jnp.zeros((B, w - 1, POOL_GROUP), jnp.float32),
                               csg[:, :T + 1 - w]], axis=1)
        cnt = jnp.minimum(jnp.arange(1, T + 1), w).astype(jnp.float32)[None, :, None]
        outs.append(((csg[:, 1:] - lag) / cnt).astype(u.dtype) - u[..., sl])
    pooled = jnp.stack(outs, axis=2)
    mixed = jnp.einsum('btgc,gcd->btgd', pooled, pool_w).reshape(B, T, C)
    return mixed * pool_scale


def conv_mixer(xin, b_gate, c_gate, conv_w):
    T = xin.shape[1]
    u = jnp.pad(c_gate * xin, ((0, 0), (CONV_WIDTH - 1, 0), (0, 0)))
    y = sum(u[:, k:k + T] * conv_w[k] for k in range(CONV_WIDTH))
    return b_gate * y


def fox_mixer(q, k, v, f_logit, f_bias):
    B, T = q.shape[:2]
    q = q.reshape(B, T, FOX_HEADS, HEAD_DIM) * (HEAD_DIM ** -0.5)
    k = k.reshape(B, T, FOX_HEADS, HEAD_DIM)
    v = v.reshape(B, T, FOX_HEADS, HEAD_DIM)
    logf = jax.nn.log_sigmoid(f_logit.astype(jnp.float32) + f_bias.astype(jnp.float32))
    c = jnp.cumsum(logf, axis=1)
    c_keys = jnp.transpose(c, (0, 2, 1))
    kpos = jnp.arange(T)

    def one_block(args):
        qi, q_blk, c_blk = args
        t = qi * Q_BLOCK + jnp.arange(Q_BLOCK)
        s = jnp.einsum('bqhd,bkhd->bhqk', q_blk, k).astype(jnp.float32)
        s = s + jnp.transpose(c_blk, (0, 2, 1))[..., None] - c_keys[:, :, None, :]
        p = masked_softmax(s, (kpos[None, :] <= t[:, None])[None, None])
        return jnp.einsum('bhqk,bkhd->bqhd', p.astype(v.dtype), v)

    o = lax.map(one_block, (jnp.arange(T // Q_BLOCK), to_blocks(q), to_blocks(c)))
    return from_blocks(o).reshape(B, T, FOX_HEADS * HEAD_DIM)


def hybrid_layer(x, norm_g, w_in, fox_f_bias, cmp_pos, cmp_w1, cmp_b1, cmp_w2, cmp_b2,
                 pool_w, pool_scale, conv_w, w_branch, w_out):
    B, T, _ = x.shape
    h = rmsnorm(x, norm_g)
    proj = h @ w_in
    split_at = np.cumsum(IN_SPLITS)[:-1].tolist()
    (nsa_q, nsa_kv, nsa_g, pool_in, conv_in, fox_qkv, fox_f,
     gate_in, merge_in) = jnp.split(proj, split_at, axis=-1)
    o_nsa = nsa_mixer(nsa_q, nsa_kv, nsa_g, cmp_pos, cmp_w1, cmp_b1, cmp_w2, cmp_b2)
    o_pool = pool_mixer(pool_in, pool_w, pool_scale)
    c_x, c_b, c_c = jnp.split(conv_in, 3, axis=-1)
    o_conv = conv_mixer(c_x, c_b, c_c, conv_w)
    f_q, f_k, f_v = jnp.split(fox_qkv, 3, axis=-1)
    o_fox = fox_mixer(f_q, f_k, f_v, fox_f, fox_f_bias)
    gates = gate_in.reshape(B, T, N_BRANCH, BRANCH_WIDTH)
    merge = merge_in.reshape(B, T, N_BRANCH, D_MODEL)
    acc = None
    for i, o in enumerate((o_nsa, o_pool, o_conv, o_fox)):
        branch = (o * jax.nn.silu(gates[:, :, i])) @ w_branch[i]
        term = jax.nn.sigmoid(merge[:, :, i]) * branch
        acc = term if acc is None else acc + term
    return x + acc @ w_out


def setup_inputs(seed: int = 0) -> dict:
    key = jax.random.key(seed)
    ks = jax.random.split(key, 20)
    f32 = jnp.float32
    nrm = lambda k, shape, scale: jax.random.normal(k, shape, f32) * scale
    cmp_in = NSA_CMP_LEN * HEAD_DIM
    return {
        "x": nrm(ks[0], (BATCH, SEQ, D_MODEL), 1.0),
        "norm_g": 1.0 + nrm(ks[1], (DEPTH, D_MODEL), 0.05),
        "w_in": nrm(ks[2], (DEPTH, D_MODEL, D_IN), D_MODEL ** -0.5),
        "fox_f_bias": 3.0 + nrm(ks[3], (DEPTH, FOX_HEADS), 0.5),
        "cmp_pos": nrm(ks[4], (DEPTH, 2, NSA_CMP_LEN, HEAD_DIM), 0.1),
        "cmp_w1": nrm(ks[5], (DEPTH, 2, cmp_in, NSA_CMP_HIDDEN), cmp_in ** -0.5),
        "cmp_b1": nrm(ks[6], (DEPTH, 2, NSA_CMP_HIDDEN), 0.02),
        "cmp_w2": nrm(ks[7], (DEPTH, 2, NSA_CMP_HIDDEN, HEAD_DIM), NSA_CMP_HIDDEN ** -0.5),
        "cmp_b2": nrm(ks[8], (DEPTH, 2, HEAD_DIM), 0.02),
        "pool_w": nrm(ks[9], (DEPTH, len(POOL_WINDOWS), POOL_GROUP, POOL_GROUP), POOL_GROUP ** -0.5),
        "pool_scale": 1.0 + nrm(ks[10], (DEPTH, BRANCH_WIDTH), 0.1),
        "conv_w": nrm(ks[11], (DEPTH, CONV_WIDTH, BRANCH_WIDTH), CONV_WIDTH ** -0.5),
        "w_branch": nrm(ks[12], (DEPTH, N_BRANCH, BRANCH_WIDTH, D_MODEL), BRANCH_WIDTH ** -0.5),
        "w_out": nrm(ks[13], (DEPTH, D_MODEL, D_MODEL), D_MODEL ** -0.5),
        "final_norm_g": 1.0 + nrm(ks[14], (D_MODEL,), 0.05),
    }


def reference(x, norm_g, w_in, fox_f_bias, cmp_pos, cmp_w1, cmp_b1, cmp_w2, cmp_b2,
              pool_w, pool_scale, conv_w, w_branch, w_out, final_norm_g):
    for l in range(DEPTH):
        x = hybrid_layer(x, norm_g[l], w_in[l], fox_f_bias[l], cmp_pos[l], cmp_w1[l],
                         cmp_b1[l], cmp_w2[l], cmp_b2[l], pool_w[l], pool_scale[l],
                         conv_w[l], w_branch[l], w_out[l])
    return rmsnorm(x, final_norm_g)
```

```cpp
#include <hip/hip_runtime.h>
#include <hip/hip_cooperative_groups.h>
#include <cstdio>
#include <cstdint>
namespace cg = cooperative_groups;
namespace pg8 {
#define PG8_LAS __attribute__((address_space(3)))
typedef unsigned short bf16_t;
typedef short bf16x8 __attribute__((ext_vector_type(8)));
typedef float f32x4 __attribute__((ext_vector_type(4)));
typedef unsigned u32x4 __attribute__((ext_vector_type(4)));
constexpr int BM = 256, BK = 64, HALF = 128, HTB = HALF * BK * 2  , STAGE_BYTES = 8 * HTB, NXCD = 8, WGM = 8;

__host__ __device__ __forceinline__ int lds_byte(int r, int c) { const int st = (r >> 4) * 2 + (c >> 5), rr = r & 15, cc = c & 31, ob = rr * 64 + cc * 2; return st * 1024 + (ob ^ (((ob >> 9) & 1) << 5)); }
__host__ __device__ __forceinline__ void stage_rc(int b, int& R, int& C) { const int st = b / 1024, sb = b % 1024, swz = sb ^ (((sb >> 9) & 1) << 5); R = (st >> 1) * 16 + swz / 64; C = (st & 1) * 32 + (swz % 64) / 2; }
__host__ __device__ __forceinline__ int perm32(int rho) { const int n = rho >> 4, i = rho & 15; return 8 * (i >> 2) + 4 * n + (i & 3); }

struct Unit { int pm, pn; };
struct Gemm { const bf16_t* A; const bf16_t* Bt; int M, N, K; };

struct StaticOrder {
    int nM, nN, nwg, G, c;
    __host__ __device__ void init(int M, int N, int G_, int c_) { nM = M / BM; nN = N / BM; nwg = nM * nN; G = G_; c = c_; }
    __host__ __device__ bool next(int i, Unit& u) const {
        const long L = (long)i * G + c; if (L >= nwg) return false;
        int wgid = (int)L; { const int q = nwg / NXCD, r = nwg % NXCD, xcd = wgid % NXCD, off = wgid / NXCD; wgid = (xcd < r ? xcd * (q + 1) : r * (q + 1) + (xcd - r) * q) + off; }
        const int nig = WGM * nN, gid = wgid / nig, fm = gid * WGM, gsz = (nM - fm) < WGM ? (nM - fm) : WGM;
        u.pm = fm + ((wgid % nig) % gsz); u.pn = (wgid % nig) / gsz; return true;
    }
    __device__ __forceinline__ void a_ready(const Unit&) const {}
    __device__ __forceinline__ void done(const Unit&) const {}
};

__device__ __forceinline__ unsigned cvt_pk_bf16(float lo, float hi) { unsigned r; asm volatile("v_cvt_pk_bf16_f32 %0, %1, %2" : "=v"(r) : "v"(lo), "v"(hi)); return r; }
template <class Epi, class Sched, bool ALIGN_EPI = false, bool SP2 = false>
__device__ __forceinline__ void gemm_phase(PG8_LAS unsigned char* lds, const Gemm g, const Sched& S, const Epi& E) {
    int tid = threadIdx.x; asm volatile("" : "+v"(tid)); const int wid = __builtin_amdgcn_readfirstlane(tid >> 6), lane = tid & 63, wr = wid >> 2, wc = wid & 3, fr = lane & 15, fq = lane >> 4;
    const int K = g.K, nt = K / BK;
    unsigned voffA[2], voffB[2];
#pragma unroll
    for (int i = 0; i < 2; ++i) { int R, C; stage_rc(tid * 16 + i * 8192, R, C); const int Rb = Epi::PERM ? ((R & ~31) + perm32(R & 31)) : R;
        voffA[i] = (unsigned)(R * K + C) * 2u; voffB[i] = (unsigned)(Rb * K + C) * 2u; }
    const size_t kstep = (size_t)(BK * 2);
    const size_t hstep = (size_t)HALF * K * 2;
    const size_t tstep = 2 * hstep;
    const unsigned ldsw = (unsigned)wid * 1024u;
    const int aoff = lds_byte(wr * 64 + fr, fq * 8), boff = lds_byte(wc * 32 + fr, fq * 8);
#define PG8_SA(b, h) (((b) * 2 + (h)) * HTB)
#define PG8_SB(b, h) ((4 + (b) * 2 + (h)) * HTB)
#define PG8_STAGE(bufoff, gbase, voff) do { _Pragma("unroll") for (int _i = 0; _i < 2; ++_i) \
        __builtin_amdgcn_global_load_lds((const unsigned*)((const char*)(gbase) + (voff)[_i]), (PG8_LAS unsigned*)(lds + (bufoff) + ldsw + _i * 8192), 16, 0, 0); } while (0)
#define PG8_LDA(dst, b, h) do { _Pragma("unroll") for (int m = 0; m < 4; ++m) _Pragma("unroll") for (int k = 0; k < 2; ++k) dst[m][k] = *(const PG8_LAS bf16x8*)(lds + PG8_SA(b, h) + aoff + m * 2048 + k * 1024); } while (0)
#define PG8_LDB(dst, b, h) do { _Pragma("unroll") for (int n = 0; n < 2; ++n) _Pragma("unroll") for (int k = 0; k < 2; ++k) dst[n][k] = *(const PG8_LAS bf16x8*)(lds + PG8_SB(b, h) + boff + n * 2048 + k * 1024); } while (0)
#define PG8_MMA(ai, bj, At, Bt) do { __builtin_amdgcn_s_setprio(1); _Pragma("unroll") for (int m = 0; m < 4; ++m) _Pragma("unroll") for (int n = 0; n < 2; ++n) _Pragma("unroll") for (int k = 0; k < 2; ++k) \
        acc[ai][bj][m][n] = __builtin_amdgcn_mfma_f32_16x16x32_bf16(Bt[n][k], At[m][k], acc[ai][bj][m][n], 0, 0, 0); __builtin_amdgcn_s_setprio(0); } while (0)
#define PG8_WAIT_V(n) asm volatile("s_waitcnt vmcnt(" #n ")" ::: "memory")
#define PG8_WAIT_L(n) asm volatile("s_waitcnt lgkmcnt(" #n ")" ::: "memory")
#define PG8_BAR __builtin_amdgcn_s_barrier()
#define PG8_SCHED __builtin_amdgcn_sched_barrier(0)
    Unit cur, nxt; int ui = 0;
    if (!S.next(0, cur)) return;
    f32x4 acc[2][2][4][2];
#pragma unroll
    for (int a = 0; a < 2; ++a)
#pragma unroll
        for (int b = 0; b < 2; ++b)
#pragma unroll
            for (int m = 0; m < 4; ++m)
#pragma unroll
                for (int n = 0; n < 2; ++n) acc[a][b][m][n] = (f32x4){0.f, 0.f, 0.f, 0.f};
    bf16x8 At[4][2], B0[2][2], B1[2][2];
    const char* cA = (const char*)g.A + (size_t)cur.pm * tstep; const char* cB = (const char*)g.Bt + (size_t)cur.pn * tstep;
    S.a_ready(cur);
    if constexpr (SP2) {
        PG8_STAGE(PG8_SB(0, 0), cB, voffB); PG8_STAGE(PG8_SB(0, 1), cB + hstep, voffB); PG8_STAGE(PG8_SA(0, 0), cA, voffA); PG8_STAGE(PG8_SA(0, 1), cA + hstep, voffA);
        if (wr == 1) PG8_BAR;
        PG8_WAIT_V(2); PG8_BAR;
        PG8_STAGE(PG8_SB(1, 0), cB + kstep, voffB); PG8_STAGE(PG8_SA(1, 0), cA + kstep, voffA); PG8_STAGE(PG8_SB(1, 1), cB + hstep + kstep, voffB);
        PG8_WAIT_V(6); PG8_BAR;
    } else {
        PG8_STAGE(PG8_SB(0, 0), cB, voffB); PG8_STAGE(PG8_SA(0, 0), cA, voffA); PG8_STAGE(PG8_SB(0, 1), cB + hstep, voffB); PG8_STAGE(PG8_SA(0, 1), cA + hstep, voffA);
        if (wr == 1) PG8_BAR;
        PG8_WAIT_V(4); PG8_BAR;
        PG8_STAGE(PG8_SB(1, 0), cB + kstep, voffB); PG8_STAGE(PG8_SA(1, 0), cA + kstep, voffA); PG8_STAGE(PG8_SB(1, 1), cB + hstep + kstep, voffB);
        PG8_WAIT_V(6); PG8_BAR;
    }
    for (;;) {
        const bool has_next = S.next(ui + 1, nxt);
        const char* nA = has_next ? (const char*)g.A + (size_t)nxt.pm * tstep : cA; const char* nB = has_next ? (const char*)g.Bt + (size_t)nxt.pn * tstep : cB;
        for (int t = 0; t < nt; t += 2) {
            const bool last = (t == nt - 2);
            const char* a1 = cA + (size_t)(t + 1) * kstep;
            const char* a2 = last ? nA : cA + (size_t)(t + 2) * kstep; const char* b2 = last ? nB : cB + (size_t)(t + 2) * kstep;
            const char* a3 = a2 + kstep; const char* b3 = b2 + kstep;
            if (last && has_next) S.a_ready(nxt);
            if constexpr (SP2) {
            PG8_LDB(B0, 0, 0); PG8_LDB(B1, 0, 1); PG8_SCHED; PG8_LDA(At, 0, 0); PG8_STAGE(PG8_SA(1, 1), a1 + hstep, voffA);
            PG8_WAIT_V(8); PG8_WAIT_L(0); PG8_BAR; PG8_MMA(0, 0, At, B0); PG8_MMA(0, 1, At, B1); PG8_BAR; PG8_SCHED;
            PG8_LDA(At, 0, 1); PG8_STAGE(PG8_SB(0, 0), b2, voffB); PG8_STAGE(PG8_SB(0, 1), b2 + hstep, voffB); PG8_STAGE(PG8_SA(0, 0), a2, voffA);
            PG8_WAIT_V(8); PG8_WAIT_L(0); PG8_BAR; PG8_MMA(1, 0, At, B0); PG8_MMA(1, 1, At, B1); PG8_BAR; PG8_SCHED;
            PG8_LDB(B0, 1, 0); PG8_LDB(B1, 1, 1); PG8_SCHED; PG8_LDA(At, 1, 0); PG8_STAGE(PG8_SA(0, 1), a2 + hstep, voffA);
            PG8_WAIT_V(8); PG8_WAIT_L(0); PG8_BAR; PG8_MMA(0, 0, At, B0); PG8_MMA(0, 1, At, B1); PG8_BAR; PG8_SCHED;
            PG8_LDA(At, 1, 1); PG8_STAGE(PG8_SB(1, 0), b3, voffB); PG8_STAGE(PG8_SB(1, 1), b3 + hstep, voffB); PG8_STAGE(PG8_SA(1, 0), a3, voffA);
            PG8_WAIT_V(8); PG8_WAIT_L(0); PG8_BAR; PG8_MMA(1, 0, At, B0); PG8_MMA(1, 1, At, B1); PG8_BAR; PG8_SCHED;
            } else {
            PG8_LDB(B0, 0, 0); PG8_SCHED; PG8_LDA(At, 0, 0); PG8_STAGE(PG8_SA(1, 1), a1 + hstep, voffA);
            PG8_WAIT_L(8); PG8_BAR; PG8_WAIT_L(0); PG8_MMA(0, 0, At, B0); PG8_BAR; PG8_SCHED;
            PG8_LDB(B1, 0, 1); PG8_STAGE(PG8_SB(0, 0), b2, voffB);
            PG8_BAR; PG8_WAIT_L(0); PG8_MMA(0, 1, At, B1); PG8_BAR;
            PG8_LDA(At, 0, 1); PG8_STAGE(PG8_SA(0, 0), a2, voffA);
            PG8_BAR; PG8_WAIT_L(0); PG8_MMA(1, 0, At, B0); PG8_BAR; PG8_SCHED;
            PG8_STAGE(PG8_SB(0, 1), b2 + hstep, voffB);
            PG8_WAIT_V(6); PG8_BAR; PG8_MMA(1, 1, At, B1); PG8_BAR;
            PG8_LDB(B0, 1, 0); PG8_SCHED; PG8_LDA(At, 1, 0); PG8_STAGE(PG8_SA(0, 1), a2 + hstep, voffA);
            PG8_WAIT_L(8); PG8_BAR; PG8_WAIT_L(0); PG8_MMA(0, 0, At, B0); PG8_BAR; PG8_SCHED;
            PG8_LDB(B1, 1, 1); PG8_STAGE(PG8_SB(1, 0), b3, voffB);
            PG8_BAR; PG8_WAIT_L(0); PG8_MMA(0, 1, At, B1); PG8_BAR;
            PG8_LDA(At, 1, 1); PG8_STAGE(PG8_SA(1, 0), a3, voffA);
            PG8_BAR; PG8_WAIT_L(0); PG8_MMA(1, 0, At, B0); PG8_BAR; PG8_SCHED;
            PG8_STAGE(PG8_SB(1, 1), b3 + hstep, voffB);
            PG8_WAIT_V(6); PG8_BAR; PG8_MMA(1, 1, At, B1); PG8_BAR;
            }
        }
        if constexpr (ALIGN_EPI) { if (wr == 0) PG8_BAR; }
        if constexpr (!Epi::AFTER_DRAIN) { E(acc, cur, wr, wc, fr, fq); S.done(cur); }
        if (!has_next) break;
#pragma unroll
        for (int a = 0; a < 2; ++a)
#pragma unroll
            for (int b = 0; b < 2; ++b)
#pragma unroll
                for (int m = 0; m < 4; ++m)
#pragma unroll
                    for (int n = 0; n < 2; ++n) acc[a][b][m][n] = (f32x4){0.f, 0.f, 0.f, 0.f};
        cur = nxt; cA = nA; cB = nB; ++ui;
        if constexpr (ALIGN_EPI) { if (wr == 1) PG8_BAR; }
    }
    PG8_WAIT_V(0);
    if constexpr (!ALIGN_EPI) { if (wr == 0) PG8_BAR; }
    PG8_BAR;
    if constexpr (Epi::AFTER_DRAIN) { E.fused(acc, cur, wr, wc, fr, fq, lds, wid, lane); S.done(cur); }
#undef PG8_SA
#undef PG8_SB
#undef PG8_STAGE
#undef PG8_LDA
#undef PG8_LDB
#undef PG8_MMA
#undef PG8_WAIT_V
#undef PG8_WAIT_L
#undef PG8_BAR
#undef PG8_SCHED
}
}
#define LAS __attribute__((address_space(3)))
typedef unsigned short bf16_t;
typedef short bf16x8 __attribute__((ext_vector_type(8)));
typedef float f32x4 __attribute__((ext_vector_type(4)));
typedef float f32x16 __attribute__((ext_vector_type(16)));
typedef unsigned u32x4 __attribute__((ext_vector_type(4)));
typedef unsigned u32x2 __attribute__((ext_vector_type(2)));
typedef float f32x2_t __attribute__((ext_vector_type(2)));
typedef __bf16 bf16x2_t __attribute__((ext_vector_type(2)));

constexpr int T = 4096, DM = 1024, NBATCH = 16, DEPTH = 2;
#ifndef REP_P0
#define REP_P0 0
#endif
#ifndef REP_SYNC
#define REP_SYNC 0
#endif
#ifndef REP_MISC
#define REP_MISC 0
#endif
#ifndef REP_D2
#define REP_D2 0
#endif
#ifndef REP_B4
#define REP_B4 0
#endif
#ifndef REP_BALL
#define REP_BALL 0
#endif
#ifndef REP_N
#define REP_N 0
#endif
#ifndef REP_A1
#define REP_A1 0
#endif
#ifndef D1_DOUBLE
#define D1_DOUBLE 0
#endif
#ifndef REP_A
#define REP_A 0
#endif
#ifndef REP_C
#define REP_C 0
#endif
#ifndef REP_D1
#define REP_D1 0
#endif
#ifndef REP_B5
#define REP_B5 0
#endif
#ifndef REP_B23
#define REP_B23 0
#endif
#ifndef NGROUP
#define NGROUP 1
#endif
constexpr int NG = NGROUP, GB = NBATCH / NG, MG = GB * T;
constexpr int NP = 3584, NGATE = 4096, NTOT = NP + NGATE;
constexpr int DIN = 7568;
constexpr int C_Q = 0, C_KC = 256, C_VC = 320, C_KS = 384, C_VS = 448, C_KW = 512, C_VW = 576, C_POOL = 640, C_CX = 896, C_CB = 1152, C_CC = 1408,
              C_FQ = 1664, C_FK = 1920, C_FV = 2176, C_GATE = 2432, C_SM = 3456;
constexpr float LOG2E = 1.4426950408889634f;
constexpr float QS = 0.125f * LOG2E;
constexpr float NEG_INF = -INFINITY;

constexpr size_t MiB = 1u << 20;
constexpr size_t WS_CTL = 0;
constexpr size_t WS_TAB = 64 * 1024;
constexpr size_t WS_B1P = WS_TAB + 256 * 1024;
constexpr size_t WS_W2T = WS_B1P + 4096;
constexpr size_t WS_PWT = 512 * 1024;
constexpr size_t WS_W1T = 1 * MiB;
constexpr size_t WS_WBT = 3 * MiB;
constexpr size_t WS_WOT = 7 * MiB;
constexpr size_t WS_WIN = 11 * MiB;
constexpr size_t WS_RSTD = 41 * MiB;
constexpr size_t WS_CFOX = 42 * MiB;
constexpr size_t WS_KC = 43 * MiB;
constexpr size_t WS_VCT = 44 * MiB;
constexpr size_t WS_VT = 45 * MiB;
constexpr size_t SZ_VT = (size_t)6 * GB * 64 * T * 2;
constexpr size_t WS_XB = WS_VT + SZ_VT;
#if NGROUP == 1
constexpr size_t WS_AB = WS_XB;
constexpr size_t WS_PROJ = WS_XB + (size_t)MG * DM * 2;
constexpr size_t WS_TOT = WS_PROJ;
#else
constexpr size_t WS_AB = WS_XB + (size_t)MG * DM * 2;
constexpr size_t WS_TOT = WS_AB + (size_t)MG * DM * 2;
constexpr size_t WS_PROJ = WS_TOT + (size_t)MG * DM * 2;
#endif
constexpr size_t WS_GATES = WS_PROJ + (size_t)MG * NP * 2;
constexpr size_t WS_END = WS_GATES + (size_t)MG * NGATE;
static_assert(WS_END <= (size_t)1024 * MiB, "workspace map exceeds 1 GiB");

constexpr int LDS_BYTES = 147456;
constexpr int AL_K = 0, AL_V = 18432, AL_CK = 36864, AL_U = 37376, AL_KC = 40960, AL_VC = 77824, AL_IMP = 111616, AL_SEL = 128256;

__device__ __forceinline__ float bf2f(unsigned short v) { return __uint_as_float((unsigned)v << 16); }
__device__ __forceinline__ unsigned pk2(float lo, float hi) { f32x2_t v = {lo, hi}; bf16x2_t b = __builtin_convertvector(v, bf16x2_t); return __builtin_bit_cast(unsigned, b); }
__device__ __forceinline__ unsigned short f2bf(float f) { return (unsigned short)(pk2(f, 0.f) & 0xffffu); }
__device__ __forceinline__ float lo16(unsigned w) { return __uint_as_float(w << 16); }
__device__ __forceinline__ float hi16(unsigned w) { return __uint_as_float(w & 0xffff0000u); }
__device__ __forceinline__ float fexp2(float x) { return __builtin_amdgcn_exp2f(x); }
__device__ __forceinline__ float frcp(float x) { return __builtin_amdgcn_rcpf(x); }
__device__ __forceinline__ float sigmoidf_(float x) { return frcp(1.f + fexp2(-x * LOG2E)); }
__device__ __forceinline__ float siluf_(float x) { return x * sigmoidf_(x); }
__device__ __forceinline__ float wave_sum(float v) {
#pragma unroll
  for (int o = 1; o < 64; o <<= 1) v += __shfl_xor(v, o);
  return v;
}
#define LDS_BARRIER() do { asm volatile("s_waitcnt lgkmcnt(0)" ::: "memory"); __builtin_amdgcn_s_barrier(); asm volatile("" ::: "memory"); } while (0)
__device__ __forceinline__ int crow(int r, int hi) { return (r & 3) + 8 * (r >> 2) + 4 * hi; }

struct EpiA {
  static constexpr bool PERM = true, AFTER_DRAIN = false;
  bf16_t* proj; unsigned char* gates;
  __device__ __forceinline__ void operator()(const pg8::f32x4 (&acc)[2][2][4][2], const pg8::Unit& u, int wr, int wc, int fr, int fq) const {
    const int row0 = u.pm * 256 + wr * 64 + fr;
    const bool isg = u.pn >= (NP / 256);
    if (!isg) {
      const int col0 = u.pn * 256 + wc * 32 + 8 * fq;
#pragma unroll
      for (int ai = 0; ai < 2; ++ai)
#pragma unroll
        for (int m = 0; m < 4; ++m) {
          bf16_t* rowp = proj + (size_t)(row0 + ai * 128 + m * 16) * NP + col0;
#pragma unroll
          for (int bj = 0; bj < 2; ++bj) {
            const pg8::f32x4 v0 = acc[ai][bj][m][0], v1 = acc[ai][bj][m][1];
            u32x4 w; w.x = pk2(v0[0], v0[1]); w.y = pk2(v0[2], v0[3]); w.z = pk2(v1[0], v1[1]); w.w = pk2(v1[2], v1[3]);
            *(u32x4*)(rowp + bj * 128) = w;
          }
        }
    } else {
      const int col0 = (u.pn - NP / 256) * 256 + wc * 32 + 8 * fq;
#pragma unroll
      for (int ai = 0; ai < 2; ++ai)
#pragma unroll
        for (int m = 0; m < 4; ++m) {
          unsigned char* rowp = gates + (size_t)(row0 + ai * 128 + m * 16) * NGATE + col0;
#pragma unroll
          for (int bj = 0; bj < 2; ++bj) {
            const pg8::f32x4 v0 = acc[ai][bj][m][0], v1 = acc[ai][bj][m][1];
            u32x2 w; w.x = 0u; w.y = 0u;
#pragma unroll
            for (int e = 0; e < 4; ++e) {
              w.x = __builtin_amdgcn_cvt_pk_u8_f32(sigmoidf_(v0[e]) * 255.0f, e, w.x);
              w.y = __builtin_amdgcn_cvt_pk_u8_f32(sigmoidf_(v1[e]) * 255.0f, e, w.y);
            }
            *(u32x2*)(rowp + bj * 128) = w;
          }
        }
    }
  }
};
struct EpiD2 {
  static constexpr bool PERM = true, AFTER_DRAIN = false;
  const float* xin; float* xout;
  __device__ __forceinline__ void operator()(const pg8::f32x4 (&acc)[2][2][4][2], const pg8::Unit& u, int wr, int wc, int fr, int fq) const {
    const int row0 = u.pm * 256 + wr * 64 + fr, col0 = u.pn * 256 + wc * 32 + 8 * fq;
#pragma unroll
    for (int ai = 0; ai < 2; ++ai)
#pragma unroll
      for (int m = 0; m < 4; ++m) {
        const size_t off = (size_t)(row0 + ai * 128 + m * 16) * 1024 + col0;
#pragma unroll
        for (int bj = 0; bj < 2; ++bj) {
          const pg8::f32x4 x0 = *(const pg8::f32x4*)(xin + off + bj * 128), x1 = *(const pg8::f32x4*)(xin + off + bj * 128 + 4);
          *(pg8::f32x4*)(xout + off + bj * 128) = x0 + acc[ai][bj][m][0];
          *(pg8::f32x4*)(xout + off + bj * 128 + 4) = x1 + acc[ai][bj][m][1];
        }
        asm volatile("" ::: "memory");
      }
  }
};
struct Args {
  const float* x; const float* norm_g; const float* w_in; const float* fox_f_bias; const float* cmp_pos; const float* cmp_w1; const float* cmp_b1;
  const float* cmp_w2; const float* cmp_b2; const float* pool_w; const float* pool_scale; const float* conv_w; const float* w_branch; const float* w_out;
  const float* final_g; float* out; unsigned char* ws;
};

__device__ __forceinline__ int win_srccol(int n) {
  if (n < 640) return n;
  if (n < 2432) return n + 12;
  if (n < 3456) return n + 16;
  if (n < 3468) return 640 + (n - 3456);
  if (n < 3472) return 2444 + (n - 3468);
  if (n < NP) return -1;
  return 3472 + (n - NP);
}

__device__ __forceinline__ void p0_prologue(const Args& a, int gt, int ngt) {
  unsigned char* ws = a.ws;
  {
    bf16_t* dst = (bf16_t*)(ws + WS_WIN);
    const int total = DEPTH * NTOT * (DM / 8);
    for (int it = gt; it < total; it += ngt) {
      const int n = it % NTOT, r = it / NTOT, kc = r % (DM / 8), l = r / (DM / 8);
      const int sc = win_srccol(n);
      const float qs = (n < 256 || (n >= C_FQ && n < C_FQ + 256)) ? QS : 1.f;
      float v[8];
#pragma unroll
      for (int j = 0; j < 8; ++j) { const int k = kc * 8 + j; v[j] = (sc < 0) ? 0.f : a.w_in[((size_t)l * DM + k) * DIN + sc] * a.norm_g[l * DM + k] * qs; }
      u32x4 w; w.x = pk2(v[0], v[1]); w.y = pk2(v[2], v[3]); w.z = pk2(v[4], v[5]); w.w = pk2(v[6], v[7]);
      *(u32x4*)(dst + ((size_t)l * NTOT + n) * DM + kc * 8) = w;
    }
  }
  {
    bf16_t* dst = (bf16_t*)(ws + WS_WBT);
    const int total = 8 * 1024 * 32;
    for (int it = gt; it < total; it += ngt) {
      const int n = it % 1024, r = it / 1024, kc = r % 32, mi = r / 32;
      const float* src = a.w_branch + (size_t)mi * 256 * 1024;
      float v[8];
#pragma unroll
      for (int j = 0; j < 8; ++j) v[j] = src[(size_t)(kc * 8 + j) * 1024 + n];
      u32x4 w; w.x = pk2(v[0], v[1]); w.y = pk2(v[2], v[3]); w.z = pk2(v[4], v[5]); w.w = pk2(v[6], v[7]);
      *(u32x4*)(dst + ((size_t)mi * 1024 + n) * 256 + kc * 8) = w;
    }
  }
  {
    bf16_t* dst = (bf16_t*)(ws + WS_WOT);
    const int total = 2 * 1024 * 128;
    for (int it = gt; it < total; it += ngt) {
      const int n = it % 1024, r = it / 1024, kc = r % 128, l = r / 128;
      const float* src = a.w_out + (size_t)l * 1024 * 1024;
      float v[8];
#pragma unroll
      for (int j = 0; j < 8; ++j) v[j] = src[(size_t)(kc * 8 + j) * 1024 + n] * (1.0f / 255.0f);
      u32x4 w; w.x = pk2(v[0], v[1]); w.y = pk2(v[2], v[3]); w.z = pk2(v[4], v[5]); w.w = pk2(v[6], v[7]);
      *(u32x4*)(dst + ((size_t)l * 1024 + n) * 1024 + kc * 8) = w;
    }
  }
  {
    bf16_t* dst = (bf16_t*)(ws + WS_W1T);
    const int total = 4 * 128 * 256;
    for (int it = gt; it < total; it += ngt) {
      const int c = it % 128, r = it / 128, kc = r % 256, m4 = r / 256;
      const float* src = a.cmp_w1 + (size_t)m4 * 2048 * 128;
      float v[8];
#pragma unroll
      for (int j = 0; j < 8; ++j) v[j] = src[(size_t)(kc * 8 + j) * 128 + c];
      u32x4 w; w.x = pk2(v[0], v[1]); w.y = pk2(v[2], v[3]); w.z = pk2(v[4], v[5]); w.w = pk2(v[6], v[7]);
      *(u32x4*)(dst + ((size_t)m4 * 128 + c) * 2048 + kc * 8) = w;
    }
  }
  {
    bf16_t* dst = (bf16_t*)(ws + WS_W2T);
    const int total = 4 * 64 * 16;
    for (int it = gt; it < total; it += ngt) {
      const int d = it % 64, r = it / 64, kc = r % 16, m4 = r / 16;
      const float* src = a.cmp_w2 + (size_t)m4 * 128 * 64;
      float v[8];
#pragma unroll
      for (int j = 0; j < 8; ++j) v[j] = src[(size_t)(kc * 8 + j) * 64 + d];
      u32x4 w; w.x = pk2(v[0], v[1]); w.y = pk2(v[2], v[3]); w.z = pk2(v[4], v[5]); w.w = pk2(v[6], v[7]);
      *(u32x4*)(dst + ((size_t)m4 * 64 + d) * 128 + kc * 8) = w;
    }
  }
  {
    bf16_t* dst = (bf16_t*)(ws + WS_PWT);
    const int total = 8 * 64 * 8;
    for (int it = gt; it < total; it += ngt) {
      const int d = it % 64, r = it / 64, kc = r % 8, lg = r / 8;
      const float* src = a.pool_w + (size_t)lg * 4096;
      float v[8];
#pragma unroll
      for (int j = 0; j < 8; ++j) v[j] = src[(size_t)(kc * 8 + j) * 64 + d];
      u32x4 w; w.x = pk2(v[0], v[1]); w.y = pk2(v[2], v[3]); w.z = pk2(v[4], v[5]); w.w = pk2(v[6], v[7]);
      *(u32x4*)(dst + ((size_t)lg * 64 + d) * 64 + kc * 8) = w;
    }
  }
  {
    float* dst = (float*)(ws + WS_B1P);
    const int gw = gt >> 6, ngw = ngt >> 6, lane = gt & 63;
    for (int o = gw; o < 512; o += ngw) {
      const int c = o % 128, m4 = o / 128;
      const float* w1 = a.cmp_w1 + (size_t)m4 * 2048 * 128; const float* pos = a.cmp_pos + (size_t)m4 * 2048;
      float s = 0.f;
      for (int kk = lane; kk < 2048; kk += 64) s += pos[kk] * w1[(size_t)kk * 128 + c];
      s = wave_sum(s);
      if (lane == 0) dst[o] = s + a.cmp_b1[m4 * 128 + c];
    }
  }
  {
    float* tab = (float*)(ws + WS_TAB);
    for (int it = gt; it < T * 8; it += ngt) {
      const int i = it & 7, t = it >> 3;
      const float inv = powf(500000.0f, -(float)i / 8.0f);
      const float ang = (float)t * inv;
      double rev = (double)ang * 0.15915494309189535; rev -= rint(rev);
      const float rv = (float)rev;
      tab[it * 2] = __builtin_amdgcn_cosf(rv); tab[it * 2 + 1] = __builtin_amdgcn_sinf(rv);
    }
  }
  if (gt < 64) ((unsigned*)(ws + WS_CTL))[gt] = 0u;
}

__device__ __forceinline__ void phase_rows(const float* __restrict__ xin, bf16_t* __restrict__ xb, float* rstd, int M, int gw, int ngw, int lane) {
  (void)rstd;
  for (int m0 = gw * 4; m0 < M; m0 += ngw * 4) {
    f32x4 v[4][4];
#pragma unroll
    for (int r = 0; r < 4; ++r) { const f32x4* xr = (const f32x4*)(xin + (size_t)(m0 + r) * DM) + lane;
#pragma unroll
      for (int j = 0; j < 4; ++j) v[r][j] = xr[64 * j]; }
#pragma unroll
    for (int r = 0; r < 4; ++r) {
      float s = 0.f;
#pragma unroll
      for (int j = 0; j < 4; ++j) s += (v[r][j].x * v[r][j].x + v[r][j].y * v[r][j].y) + (v[r][j].z * v[r][j].z + v[r][j].w * v[r][j].w);
      s = wave_sum(s);
      const float rs = 1.0f / sqrtf(s * (1.f / DM) + 1e-6f);
      u32x2* o = (u32x2*)(xb + (size_t)(m0 + r) * DM) + lane;
#pragma unroll
      for (int j = 0; j < 4; ++j) { u32x2 w; w.x = pk2(v[r][j].x * rs, v[r][j].y * rs); w.y = pk2(v[r][j].z * rs, v[r][j].w * rs); o[64 * j] = w; }
    }
  }
}
__device__ __forceinline__ void phase_final_norm(float* xio, const float* __restrict__ g, int M, int gw, int ngw, int lane) {
  f32x4 gg[4];
#pragma unroll
  for (int j = 0; j < 4; ++j) gg[j] = ((const f32x4*)g)[64 * j + lane];
  for (int m0 = gw * 4; m0 < M; m0 += ngw * 4) {
    f32x4 v[4][4];
#pragma unroll
    for (int r = 0; r < 4; ++r) { const f32x4* xr = (const f32x4*)(xio + (size_t)(m0 + r) * DM) + lane;
#pragma unroll
      for (int j = 0; j < 4; ++j) v[r][j] = xr[64 * j]; }
#pragma unroll
    for (int r = 0; r < 4; ++r) {
      float s = 0.f;
#pragma unroll
      for (int j = 0; j < 4; ++j) s += (v[r][j].x * v[r][j].x + v[r][j].y * v[r][j].y) + (v[r][j].z * v[r][j].z + v[r][j].w * v[r][j].w);
      s = wave_sum(s);
      const float rs = 1.0f / sqrtf(s * (1.f / DM) + 1e-6f);
      f32x4* xr = (f32x4*)(xio + (size_t)(m0 + r) * DM) + lane;
#pragma unroll
      for (int j = 0; j < 4; ++j) xr[64 * j] = v[r][j] * rs * gg[j];
    }
  }
}

__device__ __forceinline__ void b1_rope(bf16_t* proj, const float* tab, int gt, int ngt) {
  const int total = MG * 8;
  for (int it = gt; it < total; it += ngt) {
    const int tok = it >> 3, slot = it & 7; if (slot >= 6) continue;
    const int col = (slot < 4 ? C_Q + slot * 64 : (slot == 4 ? C_KS : C_KW));
    const int t = tok & (T - 1);
    u32x4* p = (u32x4*)(proj + (size_t)tok * NP + col);
    const u32x4 a = p[0], b = p[1];
    const f32x4* tb = (const f32x4*)(tab + (size_t)t * 16);
    const f32x4 t0 = tb[0], t1 = tb[1], t2 = tb[2], t3 = tb[3];
    const float x1[8] = {lo16(a.x), hi16(a.x), lo16(a.y), hi16(a.y), lo16(a.z), hi16(a.z), lo16(a.w), hi16(a.w)};
    const float x2[8] = {lo16(b.x), hi16(b.x), lo16(b.y), hi16(b.y), lo16(b.z), hi16(b.z), lo16(b.w), hi16(b.w)};
    const float cs[8] = {t0.x, t0.z, t1.x, t1.z, t2.x, t2.z, t3.x, t3.z}, sn[8] = {t0.y, t0.w, t1.y, t1.w, t2.y, t2.w, t3.y, t3.w};
    float y1[8], y2[8];
#pragma unroll
    for (int i = 0; i < 8; ++i) { y1[i] = x1[i] * cs[i] - x2[i] * sn[i]; y2[i] = x2[i] * cs[i] + x1[i] * sn[i]; }
    u32x4 oa, ob; oa.x = pk2(y1[0], y1[1]); oa.y = pk2(y1[2], y1[3]); oa.z = pk2(y1[4], y1[5]); oa.w = pk2(y1[6], y1[7]);
    ob.x = pk2(y2[0], y2[1]); ob.y = pk2(y2[2], y2[3]); ob.z = pk2(y2[4], y2[5]); ob.w = pk2(y2[6], y2[7]);
    p[0] = oa; p[1] = ob;
  }
}
__device__ __forceinline__ void b2_vtrans(const bf16_t* __restrict__ proj, bf16_t* __restrict__ vt, LAS unsigned char* lds, int gw, int ngw, int wid, int lane) {
  (void)lds; (void)wid;
  const int dblk = lane & 7, tblk = lane >> 3;
  const int total = 6 * GB * 64;
#pragma unroll 2
  for (int it = gw; it < total; it += ngw) {
    const int tt = it & 63, r = it >> 6, b = r % GB, src = r / GB;
    const int col = (src == 0) ? C_VS : (src == 1 ? C_VW : C_FV + (src - 2) * 64);
    const bf16_t* g = proj + (size_t)(b * T + tt * 64 + tblk * 8) * NP + col + dblk * 8;
    u32x4 a[8];
#pragma unroll
    for (int rr = 0; rr < 8; ++rr) a[rr] = *(const u32x4*)(g + (size_t)rr * NP);
    bf16_t* o = vt + ((size_t)(src * GB + b) * 64 + dblk * 8) * T + tt * 64 + tblk * 8;
#pragma unroll
    for (int i = 0; i < 8; ++i) {
      u32x4 w;
#pragma unroll
      for (int k = 0; k < 4; ++k) {
        const unsigned lo = a[2 * k][i >> 1], hi = a[2 * k + 1][i >> 1];
        w[k] = (i & 1) ? ((lo >> 16) | (hi & 0xffff0000u)) : ((lo & 0xffffu) | (hi << 16));
      }
      *(u32x4*)(o + (size_t)i * T) = w;
    }
  }
}
__device__ __forceinline__ float logsig(float z) { return fminf(z, 0.f) - __builtin_amdgcn_logf(1.f + fexp2(-fabsf(z) * LOG2E)) * 0.6931471805599453f; }
__device__ __forceinline__ void b3_foxcum(const bf16_t* proj, const float* fbias, float* c2, LAS unsigned char* lds, int tid, int wid, int lane) {
  LAS float* wtot = (LAS float*)(lds + 140 * 1024);
  const float b0 = fbias[0], b1 = fbias[1], b2 = fbias[2], b3 = fbias[3];
  for (int bb = (int)(gridDim.x - 1 - blockIdx.x); bb < GB; bb += gridDim.x) {
    const bf16_t* p = proj + (size_t)(bb * T + tid * 8) * NP + C_SM + 12;
    u32x2 raw[8];
#pragma unroll
    for (int j = 0; j < 8; ++j) raw[j] = *(const u32x2*)(p + (size_t)j * NP);
    float v[8][4]; float s[4] = {0.f, 0.f, 0.f, 0.f};
#pragma unroll
    for (int j = 0; j < 8; ++j) {
      s[0] += logsig(lo16(raw[j].x) + b0); v[j][0] = s[0];
      s[1] += logsig(hi16(raw[j].x) + b1); v[j][1] = s[1];
      s[2] += logsig(lo16(raw[j].y) + b2); v[j][2] = s[2];
      s[3] += logsig(hi16(raw[j].y) + b3); v[j][3] = s[3];
    }
    float incl[4];
#pragma unroll
    for (int h = 0; h < 4; ++h) {
      float x = s[h];
#pragma unroll
      for (int o = 1; o < 64; o <<= 1) { const float y = __shfl_up(x, o); if (lane >= o) x += y; }
      incl[h] = x;
      if (lane == 63) wtot[wid * 4 + h] = x;
    }
    __syncthreads();
#pragma unroll
    for (int h = 0; h < 4; ++h) {
      float pre = incl[h] - s[h];
      for (int w = 0; w < wid; ++w) pre += wtot[w * 4 + h];
      float* o = c2 + (size_t)(bb * 4 + h) * T + tid * 8;
      f32x4 o0, o1;
      o0.x = (pre + v[0][h]) * LOG2E; o0.y = (pre + v[1][h]) * LOG2E; o0.z = (pre + v[2][h]) * LOG2E; o0.w = (pre + v[3][h]) * LOG2E;
      o1.x = (pre + v[4][h]) * LOG2E; o1.y = (pre + v[5][h]) * LOG2E; o1.z = (pre + v[6][h]) * LOG2E; o1.w = (pre + v[7][h]) * LOG2E;
      *(f32x4*)o = o0; *(f32x4*)(o + 4) = o1;
    }
    __syncthreads();
  }
}
__device__ __forceinline__ void b7_knorm(const bf16_t* __restrict__ proj, float* __restrict__ kn, int gw, int ngw, int lane) {
  const int total = GB * 4 * 64;
  for (int it = gw; it < total; it += ngw) {
    const int j = it & 63, h = (it >> 6) & 3, b = it >> 8;
    const u32x4* p = (const u32x4*)(proj + (size_t)(b * T + j * 64 + lane) * NP + C_FK + h * 64);
    float ss = 0.f;
#pragma unroll
    for (int c = 0; c < 8; ++c) { const u32x4 v = p[c];
      const float f[8] = {lo16(v.x), hi16(v.x), lo16(v.y), hi16(v.y), lo16(v.z), hi16(v.z), lo16(v.w), hi16(v.w)};
#pragma unroll
      for (int e = 0; e < 8; ++e) ss += f[e] * f[e]; }
#pragma unroll
    for (int o = 1; o < 64; o <<= 1) ss = fmaxf(ss, __shfl_xor(ss, o));
    if (lane == 0) kn[it] = sqrtf(ss) * 1.001f;
  }
}
__device__ __forceinline__ void b4_compress(const bf16_t* proj, const bf16_t* w1T, const bf16_t* w2T, const float* b1p, const float* b2, const float* tab,
                                            bf16_t* kc, bf16_t* vcT, LAS unsigned char* lds, int tid, int wid, int lane) {
  const int r32 = lane & 31, hi = lane >> 5;
  LAS float* hid = (LAS float*)lds;
  LAS bf16_t* hb = (LAS bf16_t*)(lds + 2 * 32 * 132 * 4);
  LAS float* ost = (LAS float*)(lds + 2 * 32 * 132 * 4 + 32 * 136 * 2);
  for (int un = blockIdx.x; un < GB * 16; un += gridDim.x) {
    const int rt = un & 7, kv = (un >> 3) & 1, b = un >> 4;
    const int ct = wid & 3, kh = wid >> 2;
    const int n = rt * 32 + r32;
    const bf16_t* arow = proj + (size_t)(b * T + 16 * n) * NP + (kv ? C_VC : C_KC);
    const bf16_t* brow = w1T + ((size_t)kv * 128 + ct * 32 + r32) * 2048;
    f32x16 acc = {};
#pragma unroll 1
    for (int ks0 = 0; ks0 < 64; ks0 += 8) {
      bf16x8 af[8], bfr[8];
#pragma unroll
      for (int u = 0; u < 8; ++u) {
        const int kk = kh * 1024 + (ks0 + u) * 16 + hi * 8;
        af[u] = bf16x8{};
        if (n < 255) af[u] = *(const bf16x8*)(arow + (size_t)(kk >> 6) * NP + (kk & 63));
        bfr[u] = *(const bf16x8*)(brow + kk);
      }
#pragma unroll
      for (int u = 0; u < 8; ++u) acc = __builtin_amdgcn_mfma_f32_32x32x16_bf16(af[u], bfr[u], acc, 0, 0, 0);
    }
#pragma unroll
    for (int r = 0; r < 16; ++r) hid[(kh * 32 + crow(r, hi)) * 132 + ct * 32 + r32] = acc[r];
    __syncthreads();
    for (int e = tid; e < 32 * 128; e += 512) { const int rr = e >> 7, c = e & 127;
      const float v = hid[rr * 132 + c] + hid[(32 + rr) * 132 + c] + b1p[kv * 128 + c];
      hb[rr * 136 + c] = f2bf(siluf_(v)); }
    __syncthreads();
    if (wid < 2) {
      const int dt = wid; f32x16 a2 = {};
#pragma unroll
      for (int k0 = 0; k0 < 8; ++k0) {
        const bf16x8 af = *(const LAS bf16x8*)(hb + r32 * 136 + k0 * 16 + hi * 8);
        const bf16x8 bf = *(const bf16x8*)(w2T + ((size_t)kv * 64 + dt * 32 + r32) * 128 + k0 * 16 + hi * 8);
        a2 = __builtin_amdgcn_mfma_f32_32x32x16_bf16(af, bf, a2, 0, 0, 0);
      }
      const float bb = b2[kv * 64 + dt * 32 + r32];
#pragma unroll
      for (int r = 0; r < 16; ++r) ost[crow(r, hi) * 65 + dt * 32 + r32] = a2[r] + bb;
    }
    __syncthreads();
    for (int e = tid; e < 32 * 64; e += 512) {
      if (kv == 0) { const int rr = e >> 6, d = e & 63; const int nn = rt * 32 + rr; float v = ost[rr * 65 + d];
        if (d < 16) { const int i = d & 7, pos = 16 * nn + 31; const int pc = pos < T ? pos : T - 1;
          const float c = tab[(pc * 8 + i) * 2], s = tab[(pc * 8 + i) * 2 + 1];
          const float x1 = ost[rr * 65 + i], x2 = ost[rr * 65 + i + 8];
          v = (d < 8) ? (x1 * c - x2 * s) : (x2 * c + x1 * s); }
        if (nn >= 255) v = 0.f;
        kc[((size_t)b * 256 + nn) * 64 + d] = f2bf(v);
      } else { const int d = e >> 5, rr = e & 31; const int nn = rt * 32 + rr; float v = ost[rr * 65 + d]; if (nn >= 255) v = 0.f;
        vcT[((size_t)b * 64 + d) * 256 + nn] = f2bf(v); }
    }
    __syncthreads();
  }
}
__device__ __forceinline__ void b5_pool(const bf16_t* proj, const float* pool_w, const float* pool_scale, bf16_t* ab1, LAS unsigned char* lds, int tid) {
  LAS float* pl = (LAS float*)lds;
  for (int un = blockIdx.x; un < MG / 32; un += gridDim.x) {
    const int tl = tid >> 4, cg16 = tid & 15, tok = un * 32 + tl, t = tok & (T - 1);
    {
      const int c0 = cg16 * 16, gi = c0 >> 6, w = 2 << gi; const int cnt = (t + 1 < w) ? t + 1 : w;
      float s[16];
#pragma unroll
      for (int j = 0; j < 16; ++j) s[j] = 0.f;
      float u0[16];
      for (int k = 0; k < cnt; ++k) {
        const u32x4* p = (const u32x4*)(proj + (size_t)(tok - k) * NP + C_POOL + c0);
        const u32x4 a = p[0], b = p[1];
        const float v[16] = {lo16(a.x), hi16(a.x), lo16(a.y), hi16(a.y), lo16(a.z), hi16(a.z), lo16(a.w), hi16(a.w),
                             lo16(b.x), hi16(b.x), lo16(b.y), hi16(b.y), lo16(b.z), hi16(b.z), lo16(b.w), hi16(b.w)};
#pragma unroll
        for (int j = 0; j < 16; ++j) { s[j] += v[j]; if (k == 0) u0[j] = v[j]; }
      }
      const float ic = 1.0f / (float)cnt;
#pragma unroll
      for (int j = 0; j < 16; ++j) pl[tl * 260 + c0 + j] = s[j] * ic - u0[j];
    }
    __syncthreads();
    {
      const int gi = cg16 >> 2, d0 = (cg16 & 3) * 16;
      float o[16];
#pragma unroll
      for (int j = 0; j < 16; ++j) o[j] = 0.f;
      const float* wp = pool_w + (size_t)gi * 4096 + d0;
      for (int c = 0; c < 64; ++c) {
        const float pv = pl[tl * 260 + gi * 64 + c];
        const f32x4* w4 = (const f32x4*)(wp + c * 64);
#pragma unroll
        for (int q = 0; q < 4; ++q) { const f32x4 ww = w4[q]; o[4 * q] += pv * ww.x; o[4 * q + 1] += pv * ww.y; o[4 * q + 2] += pv * ww.z; o[4 * q + 3] += pv * ww.w; }
      }
      const int ch = gi * 64 + d0;
      const u32x4* gp = (const u32x4*)(proj + (size_t)tok * NP + C_GATE + 256 + ch);
      const u32x4 ga = gp[0], gb = gp[1];
      const float gv[16] = {lo16(ga.x), hi16(ga.x), lo16(ga.y), hi16(ga.y), lo16(ga.z), hi16(ga.z), lo16(ga.w), hi16(ga.w),
                            lo16(gb.x), hi16(gb.x), lo16(gb.y), hi16(gb.y), lo16(gb.z), hi16(gb.z), lo16(gb.w), hi16(gb.w)};
      float r[16];
#pragma unroll
      for (int j = 0; j < 16; ++j) r[j] = o[j] * pool_scale[ch + j] * siluf_(gv[j]);
      u32x4 w0, w1; w0.x = pk2(r[0], r[1]); w0.y = pk2(r[2], r[3]); w0.z = pk2(r[4], r[5]); w0.w = pk2(r[6], r[7]);
      w1.x = pk2(r[8], r[9]); w1.y = pk2(r[10], r[11]); w1.z = pk2(r[12], r[13]); w1.w = pk2(r[14], r[15]);
      u32x4* op = (u32x4*)(ab1 + (size_t)tok * 256 + ch); op[0] = w0; op[1] = w1;
    }
    __syncthreads();
  }
}
template <int W>
__device__ __forceinline__ void pool_window(const bf16_t* p, int t, float (&s)[8], float (&u0)[8]) {
  u32x4 v[W];
#pragma unroll
  for (int k = 0; k < W; ++k) v[k] = (k <= t) ? *(const u32x4*)(p - (size_t)k * NP) : u32x4{0u, 0u, 0u, 0u};
#pragma unroll
  for (int j = 0; j < 8; ++j) s[j] = 0.f;
#pragma unroll
  for (int k = 0; k < W; ++k) {
    const float f[8] = {lo16(v[k].x), hi16(v[k].x), lo16(v[k].y), hi16(v[k].y), lo16(v[k].z), hi16(v[k].z), lo16(v[k].w), hi16(v[k].w)};
#pragma unroll
    for (int j = 0; j < 8; ++j) { s[j] += f[j]; if (k == 0) u0[j] = f[j]; }
  }
}
__device__ __forceinline__ void b5_pool_mfma(const bf16_t* __restrict__ proj, const bf16_t* __restrict__ pwT, const float* __restrict__ pool_scale, bf16_t* __restrict__ ab1, int wid, int lane) {
  const int r32 = lane & 31, hi = lane >> 5, gi = wid & 3, th = wid >> 2, w = 2 << gi;
  bf16x8 wf[2][4];
#pragma unroll
  for (int dt = 0; dt < 2; ++dt)
#pragma unroll
    for (int k0 = 0; k0 < 4; ++k0) wf[dt][k0] = *(const bf16x8*)(pwT + ((size_t)gi * 64 + dt * 32 + r32) * 64 + k0 * 16 + hi * 8);
  for (int un = blockIdx.x; un < MG / 64; un += gridDim.x) {
    const int tok = un * 64 + th * 32 + r32, t = tok & (T - 1);
    const int cnt = (t + 1 < w) ? t + 1 : w; const float ic = 1.0f / (float)cnt;
    bf16x8 pf[4];
#pragma unroll
    for (int k0 = 0; k0 < 4; ++k0) {
      const bf16_t* p = proj + (size_t)tok * NP + C_POOL + gi * 64 + k0 * 16 + hi * 8;
      float s[8], u0[8];
      if (gi == 0) pool_window<2>(p, t, s, u0); else if (gi == 1) pool_window<4>(p, t, s, u0); else if (gi == 2) pool_window<8>(p, t, s, u0); else pool_window<16>(p, t, s, u0);
      u32x4 pw; pw.x = pk2(s[0] * ic - u0[0], s[1] * ic - u0[1]); pw.y = pk2(s[2] * ic - u0[2], s[3] * ic - u0[3]);
      pw.z = pk2(s[4] * ic - u0[4], s[5] * ic - u0[5]); pw.w = pk2(s[6] * ic - u0[6], s[7] * ic - u0[7]);
      pf[k0] = __builtin_bit_cast(bf16x8, pw);
    }
    f32x16 acc[2]; acc[0] = f32x16{}; acc[1] = f32x16{};
#pragma unroll
    for (int dt = 0; dt < 2; ++dt)
#pragma unroll
      for (int k0 = 0; k0 < 4; ++k0) acc[dt] = __builtin_amdgcn_mfma_f32_32x32x16_bf16(wf[dt][k0], pf[k0], acc[dt], 0, 0, 0);
#pragma unroll
    for (int dt = 0; dt < 2; ++dt)
#pragma unroll
      for (int g = 0; g < 4; ++g) {
        const int ch = gi * 64 + 32 * dt + 8 * g + 4 * hi;
        const u32x2 gw = *(const u32x2*)(proj + (size_t)tok * NP + C_GATE + 256 + ch);
        const f32x4 sc = *(const f32x4*)(pool_scale + ch);
        const float v0 = acc[dt][4 * g] * sc.x * siluf_(lo16(gw.x)), v1 = acc[dt][4 * g + 1] * sc.y * siluf_(hi16(gw.x));
        const float v2 = acc[dt][4 * g + 2] * sc.z * siluf_(lo16(gw.y)), v3 = acc[dt][4 * g + 3] * sc.w * siluf_(hi16(gw.y));
        u32x2 o; o.x = pk2(v0, v1); o.y = pk2(v2, v3); *(u32x2*)(ab1 + (size_t)tok * 256 + ch) = o;
      }
  }
}
__device__ __forceinline__ void b6_conv(const bf16_t* __restrict__ proj, const float* __restrict__ conv_w, bf16_t* __restrict__ ab2, int gt, int ngt) {
  const int total = MG * 32;
#pragma unroll 2
  for (int it = gt; it < total; it += ngt) {
    const int tok = it >> 5, c0 = (it & 31) * 8, t = tok & (T - 1);
    float y[8];
#pragma unroll
    for (int j = 0; j < 8; ++j) y[j] = 0.f;
#pragma unroll
    for (int k = 0; k < 3; ++k) {
      const int dt = 2 - k;
      if (t - dt >= 0) {
        const bf16_t* rp = proj + (size_t)(tok - dt) * NP;
        const u32x4 xv = *(const u32x4*)(rp + C_CX + c0), cv = *(const u32x4*)(rp + C_CC + c0);
        const float xs[8] = {lo16(xv.x), hi16(xv.x), lo16(xv.y), hi16(xv.y), lo16(xv.z), hi16(xv.z), lo16(xv.w), hi16(xv.w)};
        const float cs[8] = {lo16(cv.x), hi16(cv.x), lo16(cv.y), hi16(cv.y), lo16(cv.z), hi16(cv.z), lo16(cv.w), hi16(cv.w)};
#pragma unroll
        for (int j = 0; j < 8; ++j) y[j] += cs[j] * xs[j] * conv_w[k * 256 + c0 + j];
      }
    }
    const bf16_t* rp = proj + (size_t)tok * NP;
    const u32x4 bv = *(const u32x4*)(rp + C_CB + c0), gv = *(const u32x4*)(rp + C_GATE + 512 + c0);
    const float bs[8] = {lo16(bv.x), hi16(bv.x), lo16(bv.y), hi16(bv.y), lo16(bv.z), hi16(bv.z), lo16(bv.w), hi16(bv.w)};
    const float gs[8] = {lo16(gv.x), hi16(gv.x), lo16(gv.y), hi16(gv.y), lo16(gv.z), hi16(gv.z), lo16(gv.w), hi16(gv.w)};
    float r[8];
#pragma unroll
    for (int j = 0; j < 8; ++j) r[j] = bs[j] * y[j] * siluf_(gs[j]);
    u32x4 w; w.x = pk2(r[0], r[1]); w.y = pk2(r[2], r[3]); w.z = pk2(r[4], r[5]); w.w = pk2(r[6], r[7]);
    *(u32x4*)(ab2 + (size_t)tok * 256 + c0) = w;
  }
}
struct TileRegs { u32x4 k, v; float c; };
template <int MODE>
__device__ __forceinline__ void tile_load(TileRegs& R, const bf16_t* Kg, int kpitch, const bf16_t* Vtg, const float* cgl, int j, int tid) {
  const int row = tid >> 3, ch = tid & 7;
  R.k = *(const u32x4*)(Kg + (size_t)(64 * j + row) * kpitch + ch * 8);
  R.v = *(const u32x4*)(Vtg + (size_t)row * T + 64 * j + ch * 8);
  if (MODE == 0) { if (tid < 64) R.c = cgl[64 * j + tid]; }
}
template <int MODE>
__device__ __forceinline__ void tile_store(const TileRegs& R, LAS unsigned char* lds, int buf, int tid) {
  const int row = tid >> 3, ch = tid & 7;
  *(LAS u32x4*)(lds + AL_K + buf * 9216 + row * 144 + ch * 16) = R.k;
  *(LAS u32x4*)(lds + AL_V + buf * 9216 + row * 144 + ch * 16) = R.v;
  if (MODE == 0) { if (tid < 64) *(LAS float*)(lds + AL_CK + buf * 256 + tid * 4) = R.c; }
}
struct SoftState { float m, l; f32x16 o[2]; };
template <bool OFF = false>
__device__ __forceinline__ void softmax_pv(f32x16& s0, f32x16& s1, SoftState& st, const LAS unsigned char* Vt, int vstride, int kvoff, int r32, int hi) {
  float ra = __builtin_fmaxf(__builtin_fmaxf(s0[0], s0[1]), s1[0]), rb = __builtin_fmaxf(__builtin_fmaxf(s0[2], s0[3]), s1[1]);
  ra = __builtin_fmaxf(__builtin_fmaxf(ra, s1[2]), s1[3]);
#pragma unroll
  for (int r = 4; r < 16; r += 4) {
    ra = __builtin_fmaxf(__builtin_fmaxf(ra, s0[r]), s0[r + 1]); rb = __builtin_fmaxf(__builtin_fmaxf(rb, s0[r + 2]), s0[r + 3]);
    ra = __builtin_fmaxf(__builtin_fmaxf(ra, s1[r]), s1[r + 1]); rb = __builtin_fmaxf(__builtin_fmaxf(rb, s1[r + 2]), s1[r + 3]);
  }
  float rm = __builtin_fmaxf(ra, rb);
  rm = __builtin_fmaxf(rm, __shfl_xor(rm, 32));
  float ls = 0.f;
  if (OFF) {
    if (__any(rm > 4.0f)) {
      const float d = (rm > 4.0f) ? rm : 0.f;
      st.m += d;
      const float sc = fexp2(-d);
      st.l *= sc;
#pragma unroll
      for (int r = 0; r < 16; ++r) { st.o[0][r] *= sc; st.o[1][r] *= sc; s0[r] -= d; s1[r] -= d; }
    }
#pragma unroll
    for (int r = 0; r < 16; ++r) { s0[r] = fexp2(s0[r]); s1[r] = fexp2(s1[r]); ls += s0[r] + s1[r]; }
  } else {
    const float mnew = fmaxf(st.m, rm);
    const float mref = (mnew == NEG_INF) ? 0.f : mnew;
    if (__any(mnew > st.m)) {
      const float sc = fexp2(st.m - mref);
      st.l *= sc;
#pragma unroll
      for (int r = 0; r < 16; ++r) { st.o[0][r] *= sc; st.o[1][r] *= sc; }
    }
    st.m = mnew;
#pragma unroll
    for (int r = 0; r < 16; ++r) { s0[r] = fexp2(s0[r] - mref); s1[r] = fexp2(s1[r] - mref); ls += s0[r] + s1[r]; }
  }
  st.l += ls;
  bf16x8 pw[4];
#pragma unroll
  for (int jj = 0; jj < 2; ++jj) {
    u32x4 a, b;
    a.x = pk2(s0[8 * jj], s0[8 * jj + 1]); a.y = pk2(s0[8 * jj + 2], s0[8 * jj + 3]); a.z = pk2(s0[8 * jj + 4], s0[8 * jj + 5]); a.w = pk2(s0[8 * jj + 6], s0[8 * jj + 7]);
    b.x = pk2(s1[8 * jj], s1[8 * jj + 1]); b.y = pk2(s1[8 * jj + 2], s1[8 * jj + 3]); b.z = pk2(s1[8 * jj + 4], s1[8 * jj + 5]); b.w = pk2(s1[8 * jj + 6], s1[8 * jj + 7]);
    pw[jj] = __builtin_bit_cast(bf16x8, a); pw[2 + jj] = __builtin_bit_cast(bf16x8, b);
  }
#pragma unroll
  for (int dh = 0; dh < 2; ++dh) {
    const LAS unsigned char* vrow = Vt + (dh * 32 + r32) * vstride + kvoff + hi * 8;
#pragma unroll
    for (int jj = 0; jj < 4; ++jj) {
      const int kvb = 16 * (jj & 1) + 32 * (jj >> 1);
      const u32x2 lo = *(const LAS u32x2*)(vrow + kvb * 2), hh = *(const LAS u32x2*)(vrow + kvb * 2 + 16);
      u32x4 vv; vv.x = lo.x; vv.y = lo.y; vv.z = hh.x; vv.w = hh.y;
      st.o[dh] = __builtin_amdgcn_mfma_f32_32x32x16_bf16(__builtin_bit_cast(bf16x8, vv), pw[jj], st.o[dh], 0, 0, 0);
    }
  }
}
__device__ __forceinline__ void qk_tile_ini(f32x16& s0, f32x16& s1, const f32x16& ini, const LAS unsigned char* Kt, const bf16x8 (&qr)[4], int r32, int hi) {
  const LAS unsigned char* kb = Kt + r32 * 144 + hi * 16;
#pragma unroll
  for (int d0 = 0; d0 < 4; ++d0) {
    const bf16x8 k0 = *(const LAS bf16x8*)(kb + d0 * 32);
    const bf16x8 k1 = *(const LAS bf16x8*)(kb + 32 * 144 + d0 * 32);
    if (d0 == 0) { s0 = __builtin_amdgcn_mfma_f32_32x32x16_bf16(k0, qr[0], ini, 0, 0, 0); s1 = __builtin_amdgcn_mfma_f32_32x32x16_bf16(k1, qr[0], ini, 0, 0, 0); }
    else { s0 = __builtin_amdgcn_mfma_f32_32x32x16_bf16(k0, qr[d0], s0, 0, 0, 0); s1 = __builtin_amdgcn_mfma_f32_32x32x16_bf16(k1, qr[d0], s1, 0, 0, 0); }
  }
}
__device__ __forceinline__ void qk_tile(f32x16& s0, f32x16& s1, const LAS unsigned char* Kt, const bf16x8 (&qr)[4], int r32, int hi) {
  const LAS unsigned char* kb = Kt + r32 * 144 + hi * 16;
#pragma unroll
  for (int d0 = 0; d0 < 4; ++d0) {
    const bf16x8 k0 = *(const LAS bf16x8*)(kb + d0 * 32);
    const bf16x8 k1 = *(const LAS bf16x8*)(kb + 32 * 144 + d0 * 32);
    s0 = __builtin_amdgcn_mfma_f32_32x32x16_bf16(k0, qr[d0], s0, 0, 0, 0);
    s1 = __builtin_amdgcn_mfma_f32_32x32x16_bf16(k1, qr[d0], s1, 0, 0, 0);
  }
}
template <int MODE>
__device__ __forceinline__ void flash_loop(LAS unsigned char* lds, int jlo, int jhi, const bf16_t* Kg, int kpitch, const bf16_t* Vtg, const float* cgl,
                                           const bf16x8 (&qr)[4], int tq, int jw, unsigned sel_lo, unsigned sel_hi, float cq, SoftState& st, int tid, int r32, int hi) {
  TileRegs R;
  tile_load<MODE>(R, Kg, kpitch, Vtg, cgl, jlo, tid);
  tile_store<MODE>(R, lds, 0, tid);
  if (jlo < jhi) tile_load<MODE>(R, Kg, kpitch, Vtg, cgl, jlo + 1, tid);
  LDS_BARRIER();
  for (int j = jlo; j <= jhi; ++j) {
    const int buf = (j - jlo) & 1;
    if (j < jhi) tile_store<MODE>(R, lds, buf ^ 1, tid);
    if (j + 1 < jhi) tile_load<MODE>(R, Kg, kpitch, Vtg, cgl, j + 2, tid);
    if (j <= jw) {
      f32x16 s0, s1;
      if (MODE == 0) {
        const LAS unsigned char* ck = lds + AL_CK + buf * 256;
        const float cqm = cq - st.m;
#pragma unroll
        for (int g = 0; g < 4; ++g) {
          const f32x4 c0 = *(const LAS f32x4*)(ck + (8 * g + 4 * hi) * 4), c1 = *(const LAS f32x4*)(ck + (32 + 8 * g + 4 * hi) * 4);
#pragma unroll
          for (int e = 0; e < 4; ++e) { s0[4 * g + e] = cqm - c0[e]; s1[4 * g + e] = cqm - c1[e]; }
        }
        qk_tile(s0, s1, lds + AL_K + buf * 9216, qr, r32, hi);
      } else {
        float nm = -st.m;
        if (MODE == 1) { const unsigned bit = (j < 32) ? ((sel_lo >> j) & 1u) : ((sel_hi >> (j - 32)) & 1u); nm = bit ? nm : NEG_INF; }
        f32x16 ini;
#pragma unroll
        for (int r = 0; r < 16; ++r) ini[r] = nm;
        qk_tile_ini(s0, s1, ini, lds + AL_K + buf * 9216, qr, r32, hi);
      }
      const int lim_hi = tq - 64 * j;
      if (lim_hi < 63) {
#pragma unroll
        for (int r = 0; r < 16; ++r) { const int kv = crow(r, hi); if (kv > lim_hi) s0[r] = NEG_INF; if (kv + 32 > lim_hi) s1[r] = NEG_INF; }
      }
      if (MODE == 2) {
        const int lim_lo = tq - 512 - 64 * j;
        if (lim_lo >= 0) {
#pragma unroll
          for (int r = 0; r < 16; ++r) { const int kv = crow(r, hi); if (kv <= lim_lo) s0[r] = NEG_INF; if (kv + 32 <= lim_lo) s1[r] = NEG_INF; }
        }
      }
      softmax_pv<true>(s0, s1, st, lds + AL_V + buf * 9216, 144, 0, r32, hi);
    }
    LDS_BARRIER();
  }
}
__device__ __forceinline__ float merge_l(float l) { return l + __shfl_xor(l, 32); }

__device__ __forceinline__ void fox_unit(int b, int h, int qt, const bf16_t* proj, const bf16_t* vt, const float* c2, const float* kn, bf16_t* ab3, LAS unsigned char* lds, int tid, int wid, int lane) {
  const int r32 = lane & 31, hi = lane >> 5;
  const int q0 = qt * 256 + wid * 32, tq = q0 + r32;
  const size_t tok = (size_t)b * T + tq;
  bf16x8 qr[4];
#pragma unroll
  for (int d0 = 0; d0 < 4; ++d0) qr[d0] = *(const bf16x8*)(proj + tok * NP + C_FQ + h * 64 + d0 * 16 + hi * 8);
  const float* cgl = c2 + (size_t)(b * 4 + h) * T;
  const float cq = cgl[tq];
  SoftState st; st.m = 0.f; st.l = 0.f; st.o[0] = f32x16{}; st.o[1] = f32x16{};
  int jstart = 0;
  {
    float qq = 0.f;
#pragma unroll
    for (int d0 = 0; d0 < 4; ++d0) { const u32x4 w = __builtin_bit_cast(u32x4, qr[d0]);
      const float f[8] = {lo16(w.x), hi16(w.x), lo16(w.y), hi16(w.y), lo16(w.z), hi16(w.z), lo16(w.w), hi16(w.w)};
#pragma unroll
      for (int e = 0; e < 8; ++e) qq += f[e] * f[e]; }
    qq += __shfl_xor(qq, 32);
#pragma unroll
    for (int o = 1; o < 32; o <<= 1) qq = fmaxf(qq, __shfl_xor(qq, o));
    LAS float* red = (LAS float*)(lds + AL_U + 16);
    if (lane == 0) red[wid] = qq;
    __syncthreads();
    float qmax = red[0];
#pragma unroll
    for (int w = 1; w < 8; ++w) qmax = fmaxf(qmax, red[w]);
    qmax = sqrtf(qmax) * 1.001f;
    const int jhi_u = (qt * 256 + 255) >> 6;
    float kk = (lane <= jhi_u) ? kn[(size_t)(b * 4 + h) * 64 + lane] : 0.f;
    float kall = kk;
#pragma unroll
    for (int o = 1; o < 64; o <<= 1) kall = fmaxf(kall, __shfl_xor(kall, o));
    const float c_first = cgl[qt * 256];
    const float c_last = cgl[(lane <= jhi_u) ? (64 * lane + 63) : (T - 1)];
    const bool skip = (lane <= jhi_u) && (2.0f * qmax * kall + 44.0f + (c_first - c_last) < 0.f);
    const unsigned long long bal = __ballot(skip);
    jstart = (~bal == 0ull) ? 64 : (__ffsll((long long)~bal) - 1);
    if (jstart > (qt * 256) >> 6) jstart = (qt * 256) >> 6;
    __syncthreads();
  }
  flash_loop<0>(lds, jstart, (qt * 256 + 255) >> 6, proj + (size_t)b * T * NP + C_FK + h * 64, NP, vt + ((size_t)((2 + h) * GB + b) * 64) * T, cgl, qr, tq, q0 >> 6, 0u, 0u, cq, st, tid, r32, hi);
  const float inv = frcp(merge_l(st.l));
  const bf16_t* gp = proj + tok * NP + C_GATE + 768 + h * 64;
  bf16_t* op = ab3 + tok * 256 + h * 64;
#pragma unroll
  for (int dh = 0; dh < 2; ++dh)
#pragma unroll
    for (int g = 0; g < 4; ++g) {
      const int d = 32 * dh + 8 * g + 4 * hi;
      const u32x2 gw = *(const u32x2*)(gp + d);
      const float v0 = st.o[dh][4 * g] * inv * siluf_(lo16(gw.x)), v1 = st.o[dh][4 * g + 1] * inv * siluf_(hi16(gw.x));
      const float v2 = st.o[dh][4 * g + 2] * inv * siluf_(lo16(gw.y)), v3 = st.o[dh][4 * g + 3] * inv * siluf_(hi16(gw.y));
      u32x2 w; w.x = pk2(v0, v1); w.y = pk2(v2, v3); *(u32x2*)(op + d) = w;
    }
}

__device__ __forceinline__ void nsa_unit(int b, int qt, const bf16_t* proj, const bf16_t* vt, const bf16_t* kc, const bf16_t* vcT, bf16_t* ab0, LAS unsigned char* lds, int tid, int wid, int lane) {
  const int r32 = lane & 31, hi = lane >> 5, head = wid & 3, th = wid >> 2;
  const int q0 = qt * 64, ql = th * 32 + r32, tq = q0 + ql;
  const size_t tok = (size_t)b * T + tq;
#pragma unroll
  for (int i = 0; i < 4; ++i) { const int chn = tid + 512 * i; const int row = chn >> 3, c = chn & 7;
    *(LAS u32x4*)(lds + AL_KC + row * 144 + c * 16) = *(const u32x4*)(kc + ((size_t)b * 256 + row) * 64 + c * 8); }
#pragma unroll
  for (int i = 0; i < 4; ++i) { const int chn = tid + 512 * i; const int row = chn >> 5, c = chn & 31;
    *(LAS u32x4*)(lds + AL_VC + row * 528 + c * 16) = *(const u32x4*)(vcT + ((size_t)b * 64 + row) * 256 + c * 8); }
  LAS float* imp0 = (LAS float*)(lds + AL_IMP); LAS float* imp1 = (LAS float*)(lds + 0); LAS float* imp2 = (LAS float*)(lds + 16640); LAS float* imp3 = (LAS float*)(lds + 128768);
  const bool need_imp = qt >= 16;
  if (need_imp) { for (int e = tid; e < 64 * 65; e += 512) { imp0[e] = 0.f; imp1[e] = 0.f; imp2[e] = 0.f; imp3[e] = 0.f; } }
  LAS float* imp = (head == 0) ? imp0 : (head == 1) ? imp1 : (head == 2) ? imp2 : imp3;
  bf16x8 qr[4];
#pragma unroll
  for (int d0 = 0; d0 < 4; ++d0) qr[d0] = *(const bf16x8*)(proj + tok * NP + C_Q + head * 64 + d0 * 16 + hi * 8);
  __syncthreads();
  const int nmaxq = (tq - 31) >> 4;
  int ncnt = q0 / 16 + 3; if (ncnt > 255) ncnt = 255;
  const int ntc = (ncnt + 63) >> 6;
  float Bq;
  {
    LAS float* red8 = (LAS float*)(lds + AL_U + 128);
    float kq = 0.f;
    if (tid < 256) {
#pragma unroll
      for (int c = 0; c < 8; ++c) { const u32x4 v = *(const LAS u32x4*)(lds + AL_KC + tid * 144 + c * 16);
        const float f[8] = {lo16(v.x), hi16(v.x), lo16(v.y), hi16(v.y), lo16(v.z), hi16(v.z), lo16(v.w), hi16(v.w)};
#pragma unroll
        for (int e = 0; e < 8; ++e) kq += f[e] * f[e]; }
    }
#pragma unroll
    for (int o = 1; o < 64; o <<= 1) kq = fmaxf(kq, __shfl_xor(kq, o));
    if (lane == 0) red8[wid] = kq;
    __syncthreads();
    float kmax2 = red8[0];
#pragma unroll
    for (int w = 1; w < 8; ++w) kmax2 = fmaxf(kmax2, red8[w]);
    float qq = 0.f;
#pragma unroll
    for (int d0 = 0; d0 < 4; ++d0) { const u32x4 w = __builtin_bit_cast(u32x4, qr[d0]);
      const float f[8] = {lo16(w.x), hi16(w.x), lo16(w.y), hi16(w.y), lo16(w.z), hi16(w.z), lo16(w.w), hi16(w.w)};
#pragma unroll
      for (int e = 0; e < 8; ++e) qq += f[e] * f[e]; }
    qq += __shfl_xor(qq, 32);
    Bq = fminf(sqrtf(qq * kmax2) * 1.001f, 60.0f);
  }
  float l = 0.f;
  f32x16 oc[2]; oc[0] = f32x16{}; oc[1] = f32x16{};
  for (int jt = 0; jt < ntc; ++jt) {
    f32x16 s0 = {}, s1 = {};
    qk_tile(s0, s1, lds + AL_KC + jt * 64 * 144, qr, r32, hi);
    const int lim = nmaxq - 64 * jt;
#pragma unroll
    for (int r = 0; r < 16; ++r) { const int kv = crow(r, hi);
      s0[r] = (kv > lim) ? 0.f : fexp2(s0[r] - Bq); s1[r] = (kv + 32 > lim) ? 0.f : fexp2(s1[r] - Bq); l += s0[r] + s1[r]; }
    if (need_imp) {
      {
#pragma unroll
        for (int sub = 0; sub < 2; ++sub)
#pragma unroll
          for (int g = 0; g < 4; ++g) {
            const f32x16& s = sub ? s1 : s0;
            const int jg = 16 * jt + 8 * sub + 2 * g + hi;
            imp[ql * 65 + jg] += (s[4 * g] + s[4 * g + 1]) + (s[4 * g + 2] + s[4 * g + 3]);
          }
        asm volatile("s_waitcnt lgkmcnt(0)" ::: "memory");
#pragma unroll
        for (int sub = 0; sub < 2; ++sub)
#pragma unroll
          for (int g = 0; g < 4; ++g) {
            const f32x16& s = sub ? s1 : s0;
            const int jg = 16 * jt + 8 * sub + 2 * g + hi;
            if (jg + 1 < 64) imp[ql * 65 + jg + 1] += s[4 * g + 3];
          }
      }
      asm volatile("s_waitcnt lgkmcnt(0)" ::: "memory");
    }
    bf16x8 pw[4];
#pragma unroll
    for (int jj = 0; jj < 2; ++jj) {
      u32x4 a, bq;
      a.x = pk2(s0[8 * jj], s0[8 * jj + 1]); a.y = pk2(s0[8 * jj + 2], s0[8 * jj + 3]); a.z = pk2(s0[8 * jj + 4], s0[8 * jj + 5]); a.w = pk2(s0[8 * jj + 6], s0[8 * jj + 7]);
      bq.x = pk2(s1[8 * jj], s1[8 * jj + 1]); bq.y = pk2(s1[8 * jj + 2], s1[8 * jj + 3]); bq.z = pk2(s1[8 * jj + 4], s1[8 * jj + 5]); bq.w = pk2(s1[8 * jj + 6], s1[8 * jj + 7]);
      pw[jj] = __builtin_bit_cast(bf16x8, a); pw[2 + jj] = __builtin_bit_cast(bf16x8, bq);
    }
#pragma unroll
    for (int dh = 0; dh < 2; ++dh) {
      const LAS unsigned char* vrow = lds + AL_VC + (dh * 32 + r32) * 528 + jt * 128 + hi * 8;
#pragma unroll
      for (int jj = 0; jj < 4; ++jj) {
        const int kvb = 16 * (jj & 1) + 32 * (jj >> 1);
        const u32x2 lo = *(const LAS u32x2*)(vrow + kvb * 2), hh = *(const LAS u32x2*)(vrow + kvb * 2 + 16);
        u32x4 vv; vv.x = lo.x; vv.y = lo.y; vv.z = hh.x; vv.w = hh.y;
        oc[dh] = __builtin_amdgcn_mfma_f32_32x32x16_bf16(__builtin_bit_cast(bf16x8, vv), pw[jj], oc[dh], 0, 0, 0);
      }
    }
  }
  l = merge_l(l);
  const float linv = (l > 0.f) ? frcp(l) : 0.f;
#pragma unroll
  for (int r = 0; r < 16; ++r) { oc[0][r] *= linv; oc[1][r] *= linv; }
  LAS float* linvL = (LAS float*)(lds + AL_U + 256);
  if (hi == 0) linvL[head * 64 + ql] = linv;
  __syncthreads();
  LAS unsigned* selw = (LAS unsigned*)(lds + AL_SEL);
  if (qt + 1 <= 16) {
    if (tid < 64) { const unsigned long long mk = (qt + 1 >= 64) ? ~0ull : ((1ull << (qt + 1)) - 1ull); selw[tid * 2] = (unsigned)mk; selw[tid * 2 + 1] = (unsigned)(mk >> 32); }
  } else {
#pragma unroll 1
    for (int i = 0; i < 8; ++i) {
      const int qi = wid * 8 + i;
      const bool valid = lane <= qt, forced = (lane == 0) || (lane == qt) || (lane == qt - 1);
      float val = ((imp0[qi * 65 + lane] * linvL[qi] + imp1[qi * 65 + lane] * linvL[64 + qi]) + imp2[qi * 65 + lane] * linvL[128 + qi]) + imp3[qi * 65 + lane] * linvL[192 + qi];
      val = valid ? (forced ? val + 1.0e4f : val) : -1.0e30f;
      int rank = 0;
#pragma unroll 4
      for (int jj = 0; jj <= qt; ++jj) {
        const float o = __builtin_bit_cast(float, __builtin_amdgcn_readlane(__builtin_bit_cast(int, val), jj));
        rank += (o > val || (o == val && jj < lane)) ? 1 : 0;
      }
      const unsigned long long mk = __ballot(rank < 16);
      if (lane == 0) { selw[qi * 2] = (unsigned)mk; selw[qi * 2 + 1] = (unsigned)(mk >> 32); }
    }
  }
  __syncthreads();
  const unsigned sel_lo = selw[ql * 2], sel_hi = selw[ql * 2 + 1];
  const bf16_t* sm = proj + tok * NP + C_SM;
  const float g0 = sigmoidf_(bf2f(sm[head])), g1 = sigmoidf_(bf2f(sm[4 + head])), g2 = sigmoidf_(bf2f(sm[8 + head]));
  LAS float* stash = (LAS float*)(lds + AL_KC) + wid * 2048 + lane;
#pragma unroll
  for (int r = 0; r < 16; ++r) { stash[r * 64] = g0 * oc[0][r]; stash[(16 + r) * 64] = g0 * oc[1][r]; }
  f32x16 ot[2];
  {
    SoftState st; st.m = 0.f; st.l = 0.f; st.o[0] = f32x16{}; st.o[1] = f32x16{};
#ifndef NSA_NO_SEL
    flash_loop<1>(lds, 0, qt, proj + (size_t)b * T * NP + C_KS, NP, vt + ((size_t)(0 * GB + b) * 64) * T, nullptr, qr, tq, qt, sel_lo, sel_hi, 0.f, st, tid, r32, hi);
#endif
    const float sc = g1 * frcp(merge_l(st.l));
#pragma unroll
    for (int r = 0; r < 16; ++r) { stash[r * 64] += sc * st.o[0][r]; stash[(16 + r) * 64] += sc * st.o[1][r]; }
  }
  {
    SoftState st; st.m = 0.f; st.l = 0.f; st.o[0] = f32x16{}; st.o[1] = f32x16{};
#ifndef NSA_NO_WIN
    flash_loop<2>(lds, (qt >= 8) ? qt - 8 : 0, qt, proj + (size_t)b * T * NP + C_KW, NP, vt + ((size_t)(1 * GB + b) * 64) * T, nullptr, qr, tq, qt, 0u, 0u, 0.f, st, tid, r32, hi);
#endif
    const float sc = g2 * frcp(merge_l(st.l));
#pragma unroll
    for (int r = 0; r < 16; ++r) { ot[0][r] = stash[r * 64] + sc * st.o[0][r]; ot[1][r] = stash[(16 + r) * 64] + sc * st.o[1][r]; }
  }
  const bf16_t* gp = proj + tok * NP + C_GATE + head * 64;
  bf16_t* op = ab0 + tok * 256 + head * 64;
#pragma unroll
  for (int dh = 0; dh < 2; ++dh)
#pragma unroll
    for (int g = 0; g < 4; ++g) {
      const int d = 32 * dh + 8 * g + 4 * hi;
      const u32x2 gw = *(const u32x2*)(gp + d);
      const float v0 = ot[dh][4 * g] * siluf_(lo16(gw.x)), v1 = ot[dh][4 * g + 1] * siluf_(hi16(gw.x));
      const float v2 = ot[dh][4 * g + 2] * siluf_(lo16(gw.y)), v3 = ot[dh][4 * g + 3] * siluf_(hi16(gw.y));
      u32x2 w; w.x = pk2(v0, v1); w.y = pk2(v2, v3); *(u32x2*)(op + d) = w;
    }
  __syncthreads();
}
struct D1Regs { u32x4 w[4], a[2]; };
__device__ __forceinline__ void d1_load(D1Regs& R, const bf16_t* ab, const bf16_t* wbT, int pm, int pn, int s, unsigned goff) {
  const int i = s >> 2, kc = s & 3;
  const unsigned char* wbase = (const unsigned char*)(wbT + ((size_t)(i * 1024 + pn * 256)) * 256 + kc * 64);
  const unsigned char* abase = (const unsigned char*)(ab + ((size_t)i * MG + pm * 128) * 256 + kc * 64);
#pragma unroll
  for (int q = 0; q < 4; ++q) R.w[q] = *(const u32x4*)(wbase + q * 32768 + goff);
#pragma unroll
  for (int q = 0; q < 2; ++q) R.a[q] = *(const u32x4*)(abase + q * 32768 + goff);
}
__device__ __forceinline__ void d1_store(const D1Regs& R, LAS unsigned char* st, unsigned loff) {
#pragma unroll
  for (int q = 0; q < 4; ++q) *(LAS u32x4*)(st + q * 9216 + loff) = R.w[q];
#pragma unroll
  for (int q = 0; q < 2; ++q) *(LAS u32x4*)(st + 36864 + q * 9216 + loff) = R.a[q];
}
__device__ __forceinline__ void d1_compute(f32x16 (&acc)[2][2], const LAS unsigned char* st, int wn, int wm, int cperm, int r32, int hi) {
  const LAS unsigned char* wb = st + (wn * 64 + cperm) * 144 + hi * 16;
  const LAS unsigned char* abp = st + 36864 + (wm * 64 + r32) * 144 + hi * 16;
#pragma unroll
  for (int k16 = 0; k16 < 4; ++k16) {
    const bf16x8 w0 = *(const LAS bf16x8*)(wb + k16 * 32), w1 = *(const LAS bf16x8*)(wb + 32 * 144 + k16 * 32);
    const bf16x8 a0 = *(const LAS bf16x8*)(abp + k16 * 32), a1 = *(const LAS bf16x8*)(abp + 32 * 144 + k16 * 32);
    acc[0][0] = __builtin_amdgcn_mfma_f32_32x32x16_bf16(w0, a0, acc[0][0], 0, 0, 0);
    acc[0][1] = __builtin_amdgcn_mfma_f32_32x32x16_bf16(w0, a1, acc[0][1], 0, 0, 0);
    acc[1][0] = __builtin_amdgcn_mfma_f32_32x32x16_bf16(w1, a0, acc[1][0], 0, 0, 0);
    acc[1][1] = __builtin_amdgcn_mfma_f32_32x32x16_bf16(w1, a1, acc[1][1], 0, 0, 0);
  }
}
__device__ __forceinline__ void d1_compute_lite(f32x16 (&dum)[2], const LAS unsigned char* st, int wn, int wm, int cperm, int r32, int hi) {
  const LAS unsigned char* wb = st + (wn * 64 + cperm) * 144 + hi * 16;
  const LAS unsigned char* abp = st + 36864 + (wm * 64 + r32) * 144 + hi * 16;
#pragma unroll
  for (int k16 = 0; k16 < 4; ++k16) {
    const bf16x8 w0 = *(const LAS bf16x8*)(wb + k16 * 32), w1 = *(const LAS bf16x8*)(wb + 32 * 144 + k16 * 32);
    const bf16x8 a0 = *(const LAS bf16x8*)(abp + k16 * 32), a1 = *(const LAS bf16x8*)(abp + 32 * 144 + k16 * 32);
    dum[0] = __builtin_amdgcn_mfma_f32_32x32x16_bf16(w0, a0, dum[0], 0, 0, 0);
    dum[1] = __builtin_amdgcn_mfma_f32_32x32x16_bf16(w0, a1, dum[1], 0, 0, 0);
    dum[0] = __builtin_amdgcn_mfma_f32_32x32x16_bf16(w1, a0, dum[0], 0, 0, 0);
    dum[1] = __builtin_amdgcn_mfma_f32_32x32x16_bf16(w1, a1, dum[1], 0, 0, 0);
  }
}
__device__ __forceinline__ void d1_phase(const bf16_t* ab, const bf16_t* wbT, const unsigned char* gates, bf16_t* tot, LAS unsigned char* lds, int tid, int wid, int lane) {
  const int r32 = lane & 31, hi = lane >> 5, wm = wid & 1, wn = wid >> 1;
  const int cperm = (r32 & ~0xC) | ((r32 & 4) << 1) | ((r32 & 8) >> 1);
  constexpr int STG = 55296;
  const unsigned goff = (unsigned)((tid >> 3) * 512 + (tid & 7) * 16), loff = (unsigned)((tid >> 3) * 144 + (tid & 7) * 16);
  const int nunits = (MG / 128) * 4;
  const int G8 = gridDim.x >> 3, xcd = blockIdx.x & 7, jloc = blockIdx.x >> 3, upx = nunits >> 3;
#pragma unroll 1
  for (int ul = jloc; ul < upx; ul += G8) {
    const int un = xcd * upx + ul;
    const int pn = un & 3, pm = un >> 2;
    const unsigned char* gbase = gates + (size_t)(pm * 128) * NGATE + pn * 256;
    const unsigned ggo = (unsigned)((tid >> 4) * NGATE + (tid & 15) * 16), glo = (unsigned)((tid >> 4) * 264 + (tid & 15) * 16);
    f32x16 acc[2][2]; u32x4 tp[2][2][2];
#pragma unroll
    for (int x = 0; x < 2; ++x)
#pragma unroll
      for (int y = 0; y < 2; ++y) { acc[x][y] = f32x16{}; tp[x][y][0] = u32x4{0u, 0u, 0u, 0u}; tp[x][y][1] = u32x4{0u, 0u, 0u, 0u}; }
    D1Regs R0, R1;
    f32x16 dum[2];
    if (D1_DOUBLE) { dum[0] = f32x16{}; dum[1] = f32x16{}; }
    u32x4 gq[4];
#pragma unroll
    for (int q = 0; q < 4; ++q) gq[q] = *(const u32x4*)(gbase + (size_t)(q * 32) * NGATE + ggo);
    d1_load(R0, ab, wbT, pm, pn, 0, goff);
    d1_load(R1, ab, wbT, pm, pn, 1, goff);
    d1_store(R0, lds, loff);
    LDS_BARRIER();
#pragma unroll 1
    for (int i = 0; i < 4; ++i) {
      const int s0 = 4 * i;
      d1_load(R0, ab, wbT, pm, pn, s0 + 2, goff);
      d1_compute(acc, lds, wn, wm, cperm, r32, hi); if (D1_DOUBLE) d1_compute_lite(dum, lds, wn, wm, cperm, r32, hi);
      d1_store(R1, lds + STG, loff);
      LDS_BARRIER();
      {
        d1_load(R1, ab, wbT, pm, pn, s0 + 3, goff);
        d1_compute(acc, lds + STG, wn, wm, cperm, r32, hi); if (D1_DOUBLE) d1_compute_lite(dum, lds + STG, wn, wm, cperm, r32, hi);
#pragma unroll
        for (int q = 0; q < 4; ++q) *(LAS u32x4*)(lds + 2 * STG + q * 32 * 264 + glo) = gq[q];
        d1_store(R0, lds, loff);
      }
      LDS_BARRIER();
      if (i < 3) d1_load(R0, ab, wbT, pm, pn, s0 + 4, goff);
      d1_compute(acc, lds, wn, wm, cperm, r32, hi); if (D1_DOUBLE) d1_compute_lite(dum, lds, wn, wm, cperm, r32, hi);
      d1_store(R1, lds + STG, loff);
      LDS_BARRIER();
      if (i < 3) {
#pragma unroll
        for (int q = 0; q < 4; ++q) gq[q] = *(const u32x4*)(gbase + (size_t)(q * 32) * NGATE + (i + 1) * 1024 + ggo);
        d1_load(R1, ab, wbT, pm, pn, s0 + 5, goff);
      }
      d1_compute(acc, lds + STG, wn, wm, cperm, r32, hi); if (D1_DOUBLE) d1_compute_lite(dum, lds + STG, wn, wm, cperm, r32, hi);
#pragma unroll
      for (int tm = 0; tm < 2; ++tm)
#pragma unroll
        for (int tn = 0; tn < 2; ++tn)
#pragma unroll
          for (int p = 0; p < 2; ++p) {
            const u32x2 g = *(const LAS u32x2*)(lds + 2 * STG + (wm * 64 + tn * 32 + r32) * 264 + wn * 64 + tm * 32 + 16 * p + 8 * hi);
            const u32x4 t = tp[tm][tn][p]; const f32x16& c = acc[tm][tn];
            u32x4 o;
            o.x = pk2(lo16(t.x) + (float)(g.x & 0xffu) * c[8 * p + 0], hi16(t.x) + (float)((g.x >> 8) & 0xffu) * c[8 * p + 1]);
            o.y = pk2(lo16(t.y) + (float)((g.x >> 16) & 0xffu) * c[8 * p + 2], hi16(t.y) + (float)(g.x >> 24) * c[8 * p + 3]);
            o.z = pk2(lo16(t.z) + (float)(g.y & 0xffu) * c[8 * p + 4], hi16(t.z) + (float)((g.y >> 8) & 0xffu) * c[8 * p + 5]);
            o.w = pk2(lo16(t.w) + (float)((g.y >> 16) & 0xffu) * c[8 * p + 6], hi16(t.w) + (float)(g.y >> 24) * c[8 * p + 7]);
            tp[tm][tn][p] = o;
          }
#pragma unroll
      for (int x = 0; x < 2; ++x)
#pragma unroll
        for (int y = 0; y < 2; ++y) acc[x][y] = f32x16{};
      if (i < 3) d1_store(R0, lds, loff);
      LDS_BARRIER();
    }
    if (D1_DOUBLE) { asm volatile("" :: "v"(dum[0]), "v"(dum[1])); }
    bf16_t* trow = tot + (size_t)(pm * 128 + wm * 64 + r32) * 1024 + pn * 256 + wn * 64 + 8 * hi;
#pragma unroll
    for (int tm = 0; tm < 2; ++tm)
#pragma unroll
      for (int tn = 0; tn < 2; ++tn)
#pragma unroll
        for (int p = 0; p < 2; ++p) {
          *(u32x4*)(trow + (size_t)tn * 32 * 1024 + tm * 32 + 16 * p) = tp[tm][tn][p];
        }
  }
}
#define XB_TMO      128
#define XB_XCNT(j)  (256  + 64 * (j))
#define XB_XSUB(j)  (1280 + 64 * (j))
#define XB_XGEN(j)  (2304 + 64 * (j))
#define XB_TOP      3328
#define XB_TOPGEN   3392
#define XCD_BAR_WORDS 3456
#define XB_SPIN_CAP (1u << 18)

__device__ __forceinline__ unsigned xb_ld(unsigned* p)              { return __hip_atomic_load(p, __ATOMIC_RELAXED, __HIP_MEMORY_SCOPE_AGENT); }
__device__ __forceinline__ unsigned xb_add(unsigned* p, unsigned v) { return __hip_atomic_fetch_add(p, v, __ATOMIC_RELAXED, __HIP_MEMORY_SCOPE_AGENT); }
__device__ __forceinline__ unsigned xb_xcc_id() { return (unsigned)__builtin_amdgcn_s_getreg((3 << 11) | 20) & 0xFu; }
#define XB_SPIN(cond, bar) do { unsigned _sp = 0; while (cond) { __builtin_amdgcn_s_sleep(1); \
    if ((++_sp & 255u) == 0u) { if (xb_ld(&(bar)[XB_TMO])) break; if (_sp > XB_SPIN_CAP) { atomicAdd(&(bar)[XB_TMO], 1u); break; } } } } while (0)

struct XcdBarrier {
    unsigned* bar; unsigned x;
    volatile LAS unsigned* st;
};

__device__ __forceinline__ XcdBarrier xcd_barrier_post(unsigned* bar, volatile LAS unsigned* st) {
    XcdBarrier b; b.bar = bar; b.x = xb_xcc_id(); b.st = st;
    if (threadIdx.x == 0) (void)xb_add(&bar[XB_XCNT(b.x)], 1u);
    return b;
}
__device__ __forceinline__ void xcd_barrier_complete(unsigned* bar, unsigned x, unsigned& nloc, unsigned& nx) {
    const unsigned G = gridDim.x * gridDim.y * gridDim.z;
    unsigned sum, cnt, mine, sp = 0u;
    for (;;) {
        sum = 0u; cnt = 0u; mine = 0u;
#pragma unroll
        for (unsigned j = 0; j < 16; ++j) { const unsigned c = xb_ld(&bar[XB_XCNT(j)]); sum += c; cnt += (c > 0u) ? 1u : 0u; mine = (j == x) ? c : mine; }
        if (sum == G) break;
        __builtin_amdgcn_s_sleep(1);
        if ((++sp & 255u) == 0u) { if (xb_ld(&bar[XB_TMO])) break; if (sp > XB_SPIN_CAP) { atomicAdd(&bar[XB_TMO], 1u); break; } }
    }
    nloc = mine > 0u ? mine : 1u; nx = cnt > 0u ? cnt : 1u;
}

__device__ __forceinline__ void xcd_barrier(const XcdBarrier& b) {
    asm volatile("s_waitcnt vmcnt(0)" ::: "memory");
    __syncthreads();
    if (threadIdx.x == 0) {
        unsigned* bar = b.bar;
        __builtin_amdgcn_s_waitcnt(0);
        unsigned nloc = b.st[0], nx = b.st[1];
        if (nloc == 0u) { xcd_barrier_complete(bar, b.x, nloc, nx); b.st[0] = nloc; b.st[1] = nx; }
        const unsigned old = xb_add(&bar[XB_XSUB(b.x)], 1u);
        const unsigned gen = old / nloc;
        if (old + 1u == (gen + 1u) * nloc) {
            __builtin_amdgcn_fence(__ATOMIC_RELEASE, "agent");
            asm volatile("s_waitcnt vmcnt(0)" ::: "memory");
            const unsigned og = xb_add(&bar[XB_TOP], 1u);
            const unsigned tg = og / nx;
            if (og + 1u == (tg + 1u) * nx) xb_add(&bar[XB_TOPGEN], 1u);
            else XB_SPIN(xb_ld(&bar[XB_TOPGEN]) == tg, bar);
            __builtin_amdgcn_fence(__ATOMIC_ACQUIRE, "agent");
            xb_add(&bar[XB_XGEN(b.x)], 1u);
            asm volatile("s_waitcnt vmcnt(0)" ::: "memory");
        } else {
            XB_SPIN(xb_ld(&bar[XB_XGEN(b.x)]) == gen, bar);
            __builtin_amdgcn_fence(__ATOMIC_ACQUIRE, "agent");
            asm volatile("s_waitcnt vmcnt(0)" ::: "memory");
        }
    }
    __syncthreads();
}

constexpr int CW_BAR = 1024;
constexpr int LDS_BARST = LDS_BYTES - 64;
#define LAYER_BODY(g, l) do { \
      { PHASE_BEGIN(); \
        const float* xin = (l == 0) ? a.x + (size_t)g * MG * DM : a.out + (size_t)g * MG * DM; \
        for (int rep = 0; rep < 1 + REP_MISC + REP_N; ++rep) phase_rows(xin, xb, rstd, MG, gw, ngw, lane); \
        if (l == 0 && g > 0) phase_final_norm(a.out + (size_t)(g - 1) * MG * DM, a.final_g, MG, gw, ngw, lane); \
      } \
      xcd_barrier(xbar); if (REP_SYNC) xcd_barrier(xbar); \
      { PHASE_BEGIN(); \
        pg8::Gemm gm{xb, (const bf16_t*)(ws + WS_WIN) + (size_t)l * NTOT * DM, MG, NTOT, DM}; \
        pg8::StaticOrder S; S.init(MG, NTOT, G, (int)blockIdx.x); \
        EpiA E{proj, gates}; \
        for (int rep = 0; rep < 1 + REP_A; ++rep) { pg8::gemm_phase<EpiA, pg8::StaticOrder, true, true>(lds, gm, S, E); __syncthreads(); } \
        if (REP_A1) { pg8::Gemm gm1{xb, (const bf16_t*)(ws + WS_WIN) + (size_t)l * NTOT * DM, MG, NP, DM}; pg8::StaticOrder S1; S1.init(MG, NP, G, (int)blockIdx.x); pg8::gemm_phase<EpiA, pg8::StaticOrder, true, true>(lds, gm1, S1, E); __syncthreads(); } \
      } \
      xcd_barrier(xbar); if (REP_SYNC) xcd_barrier(xbar); \
      { PHASE_BEGIN(); \
        b1_rope(proj, tab, gt, ngt); \
      } { PHASE_BEGIN(); \
        for (int rep = 0; rep < 1 + REP_B23 + REP_BALL; ++rep) { b2_vtrans(proj, vt, lds, gw, ngw, wid, lane); \
        b3_foxcum(proj, a.fox_f_bias + l * 4, c2, lds, tid, wid, lane); b7_knorm(proj, rstd, gw, ngw, lane); } \
        __syncthreads(); \
      } { PHASE_BEGIN(); \
        for (int rep = 0; rep < 1 + REP_MISC + REP_B4 + REP_BALL; ++rep) b4_compress(proj, (const bf16_t*)(ws + WS_W1T) + (size_t)l * 2 * 128 * 2048, (const bf16_t*)(ws + WS_W2T) + (size_t)l * 2 * 64 * 128, \
                    (const float*)(ws + WS_B1P) + l * 256, a.cmp_b2 + l * 128, tab, kc, vcT, lds, tid, wid, lane); \
        __syncthreads(); \
      } { PHASE_BEGIN(); \
        for (int rep = 0; rep < 1 + REP_B5 + REP_BALL; ++rep) b5_pool_mfma(proj, (const bf16_t*)(ws + WS_PWT) + (size_t)l * 4 * 4096, a.pool_scale + l * 256, ab + (size_t)1 * MG * 256, wid, lane); \
      } { PHASE_BEGIN(); \
        for (int rep = 0; rep < 1 + REP_MISC + REP_BALL; ++rep) b6_conv(proj, a.conv_w + l * 768, ab + (size_t)2 * MG * 256, gt, ngt); \
      } \
      xcd_barrier(xbar); if (REP_SYNC) xcd_barrier(xbar); \
      { PHASE_BEGIN(); \
        for (int rep = 0; rep < 1 + REP_C; ++rep) { \
        unsigned* ctr = (unsigned*)(ws + WS_CTL) + (g * DEPTH + l) + 8 * rep; \
        LAS unsigned* uw = (LAS unsigned*)(lds + AL_U); \
        constexpr int NUNITS = 16 * 8 * GB; \
        for (;;) { \
          if (tid == 0) uw[0] = atomicAdd(ctr, 1u); \
          __syncthreads(); \
          const unsigned u = uw[0]; \
          __syncthreads(); \
          if (u >= (unsigned)NUNITS) break; \
          if (u < (unsigned)(64 * GB)) nsa_unit((int)u % GB, 63 - (int)u / GB, proj, vt, kc, vcT, ab, lds, tid, wid, lane); \
          else { const int v = (int)u - 64 * GB, r = v % (4 * GB); fox_unit(r >> 2, r & 3, 15 - v / (4 * GB), proj, vt, c2, rstd, ab + (size_t)3 * MG * 256, lds, tid, wid, lane); } \
        } \
        __syncthreads(); } \
      } \
      xcd_barrier(xbar); if (REP_SYNC) xcd_barrier(xbar); \
      { PHASE_BEGIN(); \
        for (int rep = 0; rep < 1 + REP_D1; ++rep) d1_phase(ab, (const bf16_t*)(ws + WS_WBT) + (size_t)l * 4 * 1024 * 256, gates, tot, lds, tid, wid, lane); \
      } \
      xcd_barrier(xbar); if (REP_SYNC) xcd_barrier(xbar); \
      { PHASE_BEGIN(); \
        const float* xin = (l == 0) ? a.x + (size_t)g * MG * DM : a.out + (size_t)g * MG * DM; \
        pg8::Gemm gm{tot, (const bf16_t*)(ws + WS_WOT) + (size_t)l * 1024 * 1024, MG, DM, DM}; \
        pg8::StaticOrder S; S.init(MG, DM, G, (int)blockIdx.x); \
        EpiD2 E{xin, a.out + (size_t)g * MG * DM}; \
        for (int rep = 0; rep < 1 + ((l == 0) ? 2 * REP_D2 : 0); ++rep) { pg8::gemm_phase<EpiD2, pg8::StaticOrder, true, true>(lds, gm, S, E); __syncthreads(); } \
      } \
      xcd_barrier(xbar); if (REP_SYNC) xcd_barrier(xbar); \
 \
  } while (0)
__global__ void __launch_bounds__(512, 2) hybrid_fwd(Args a) {
  extern __shared__ __attribute__((aligned(16))) unsigned char lds_raw[];
  LAS unsigned char* lds = (LAS unsigned char*)lds_raw;
  cg::grid_group grid = cg::this_grid();
  const int tid0 = threadIdx.x;
  const int G = gridDim.x;
  const int ngt = G * 512, ngw = G * 8;
#define PHASE_BEGIN() int tid = tid0; asm volatile("" : "+v"(tid)); const int lane = tid & 63, wid = __builtin_amdgcn_readfirstlane(tid >> 6); \
      const int gt = blockIdx.x * 512 + tid, gw = blockIdx.x * 8 + wid; (void)lane; (void)wid; (void)gt; (void)gw; \
      __attribute__((address_space(1))) unsigned char* wsl_ = (__attribute__((address_space(1))) unsigned char*)a.ws; asm volatile("" : "+s"(wsl_)); unsigned char* ws = (unsigned char*)wsl_; \
      float* rstd = (float*)(ws + WS_RSTD); float* c2 = (float*)(ws + WS_CFOX); const float* tab = (const float*)(ws + WS_TAB); \
      bf16_t* kc = (bf16_t*)(ws + WS_KC); bf16_t* vcT = (bf16_t*)(ws + WS_VCT); bf16_t* vt = (bf16_t*)(ws + WS_VT); \
      bf16_t* xb = (bf16_t*)(ws + WS_XB); bf16_t* ab = (bf16_t*)(ws + WS_AB); bf16_t* tot = (bf16_t*)(ws + WS_TOT); \
      bf16_t* proj = (bf16_t*)(ws + WS_PROJ); unsigned char* gates = (unsigned char*)(ws + WS_GATES); \
      (void)rstd; (void)c2; (void)tab; (void)kc; (void)vcT; (void)vt; (void)xb; (void)ab; (void)tot; (void)proj; (void)gates;

  if (tid0 < 16) ((LAS unsigned*)(lds + LDS_BARST))[tid0] = 0u;
  __syncthreads();
  XcdBarrier xbar = xcd_barrier_post((unsigned*)(a.ws + WS_CTL) + CW_BAR, (volatile LAS unsigned*)(lds + LDS_BARST));
  for (int rep = 0; rep < 1 + REP_P0; ++rep) { const int gt = blockIdx.x * 512 + tid0; p0_prologue(a, gt, ngt); }
  grid.sync();

  LAYER_BODY(0, 0); LAYER_BODY(0, 1);
#if NGROUP > 1
  LAYER_BODY(1, 0); LAYER_BODY(1, 1);
#endif
#if NGROUP > 2
  LAYER_BODY(2, 0); LAYER_BODY(2, 1); LAYER_BODY(3, 0); LAYER_BODY(3, 1);
#endif
  { const int lane = tid0 & 63, gw = blockIdx.x * 8 + (tid0 >> 6); phase_final_norm(a.out + (size_t)(NG - 1) * MG * DM, a.final_g, MG, gw, ngw, lane); }
}

extern "C" void kernel_launch(void* const* d_in, const int* in_sizes, int n_in, void* d_out, int out_size, void* d_ws, size_t ws_size, hipStream_t stream) {
  static int grid = 0;
  if (!grid) {
    int dev = 0, cus = 0, per = 0;
    (void)hipGetDevice(&dev); (void)hipDeviceGetAttribute(&cus, hipDeviceAttributeMultiprocessorCount, dev);
    (void)hipFuncSetAttribute((const void*)hybrid_fwd, hipFuncAttributeMaxDynamicSharedMemorySize, LDS_BYTES);
    (void)hipOccupancyMaxActiveBlocksPerMultiprocessor(&per, (const void*)hybrid_fwd, 512, LDS_BYTES);
    if (per < 1) per = 1;
    grid = cus * per;
    if (ws_size < WS_END) fprintf(stderr, "workspace too small: %zu < %zu\n", ws_size, (size_t)WS_END);
  }
  (void)hipMemsetAsync((char*)d_ws + WS_CTL, 0, 64 * 1024, stream);
  Args a{};
  a.x = (const float*)d_in[0]; a.norm_g = (const float*)d_in[1]; a.w_in = (const float*)d_in[2]; a.fox_f_bias = (const float*)d_in[3];
  a.cmp_pos = (const float*)d_in[4]; a.cmp_w1 = (const float*)d_in[5]; a.cmp_b1 = (const float*)d_in[6]; a.cmp_w2 = (const float*)d_in[7];
  a.cmp_b2 = (const float*)d_in[8]; a.pool_w = (const float*)d_in[9]; a.pool_scale = (const float*)d_in[10]; a.conv_w = (const float*)d_in[11];
  a.w_branch = (const float*)d_in[12]; a.w_out = (const float*)d_in[13]; a.final_g = (const float*)d_in[14];
  a.out = (float*)d_out; a.ws = (unsigned char*)d_ws;
  void* args[] = {&a};
  hipError_t e = hipLaunchCooperativeKernel((const void*)hybrid_fwd, dim3(grid), dim3(512), args, LDS_BYTES, stream);
  if (e != hipSuccess) fprintf(stderr, "cooperative launch failed: %s (grid %d)\n", hipGetErrorString(e), grid);
}
```

```cpp
#include <hip/hip_runtime.h>
#include <hip/hip_cooperative_groups.h>
#include <cstdio>
#include <cstdint>
namespace cg = cooperative_groups;
namespace pg8 {
#define PG8_LAS __attribute__((address_space(3)))
typedef unsigned short bf16_t;
typedef short bf16x8 __attribute__((ext_vector_type(8)));
typedef float f32x4 __attribute__((ext_vector_type(4)));
typedef unsigned u32x4 __attribute__((ext_vector_type(4)));
constexpr int BM = 256, BK = 64, HALF = 128, HTB = HALF * BK * 2  , STAGE_BYTES = 8 * HTB, NXCD = 8, WGM = 8;

__host__ __device__ __forceinline__ int lds_byte(int r, int c) { const int st = (r >> 4) * 2 + (c >> 5), rr = r & 15, cc = c & 31, ob = rr * 64 + cc * 2; return st * 1024 + (ob ^ (((ob >> 9) & 1) << 5)); }
__host__ __device__ __forceinline__ void stage_rc(int b, int& R, int& C) { const int st = b / 1024, sb = b % 1024, swz = sb ^ (((sb >> 9) & 1) << 5); R = (st >> 1) * 16 + swz / 64; C = (st & 1) * 32 + (swz % 64) / 2; }
__host__ __device__ __forceinline__ int perm32(int rho) { const int n = rho >> 4, i = rho & 15; return 8 * (i >> 2) + 4 * n + (i & 3); }

struct Unit { int pm, pn; };
struct Gemm { const bf16_t* A; const bf16_t* Bt; int M, N, K; };

struct StaticOrder {
    int nM, nN, nwg, G, c;
    __host__ __device__ void init(int M, int N, int G_, int c_) { nM = M / BM; nN = N / BM; nwg = nM * nN; G = G_; c = c_; }
    __host__ __device__ bool next(int i, Unit& u) const {
        const long L = (long)i * G + c; if (L >= nwg) return false;
        int wgid = (int)L; { const int q = nwg / NXCD, r = nwg % NXCD, xcd = wgid % NXCD, off = wgid / NXCD; wgid = (xcd < r ? xcd * (q + 1) : r * (q + 1) + (xcd - r) * q) + off; }
        const int nig = WGM * nN, gid = wgid / nig, fm = gid * WGM, gsz = (nM - fm) < WGM ? (nM - fm) : WGM;
        u.pm = fm + ((wgid % nig) % gsz); u.pn = (wgid % nig) / gsz; return true;
    }
    __device__ __forceinline__ void a_ready(const Unit&) const {}
    __device__ __forceinline__ void done(const Unit&) const {}
};

__device__ __forceinline__ unsigned cvt_pk_bf16(float lo, float hi) { unsigned r; asm volatile("v_cvt_pk_bf16_f32 %0, %1, %2" : "=v"(r) : "v"(lo), "v"(hi)); return r; }
template <class Epi, class Sched, bool ALIGN_EPI = false, bool SP2 = false>
__device__ __forceinline__ void gemm_phase(PG8_LAS unsigned char* lds, const Gemm g, const Sched& S, const Epi& E) {
    int tid = threadIdx.x; asm volatile("" : "+v"(tid)); const int wid = __builtin_amdgcn_readfirstlane(tid >> 6), lane = tid & 63, wr = wid >> 2, wc = wid & 3, fr = lane & 15, fq = lane >> 4;
    const int K = g.K, nt = K / BK;
    unsigned voffA[2], voffB[2];
#pragma unroll
    for (int i = 0; i < 2; ++i) { int R, C; stage_rc(tid * 16 + i * 8192, R, C); const int Rb = Epi::PERM ? ((R & ~31) + perm32(R & 31)) : R;
        voffA[i] = (unsigned)(R * K + C) * 2u; voffB[i] = (unsigned)(Rb * K + C) * 2u; }
    const size_t kstep = (size_t)(BK * 2);
    const size_t hstep = (size_t)HALF * K * 2;
    const size_t tstep = 2 * hstep;
    const unsigned ldsw = (unsigned)wid * 1024u;
    const int aoff = lds_byte(wr * 64 + fr, fq * 8), boff = lds_byte(wc * 32 + fr, fq * 8);
#define PG8_SA(b, h) (((b) * 2 + (h)) * HTB)
#define PG8_SB(b, h) ((4 + (b) * 2 + (h)) * HTB)
#define PG8_STAGE(bufoff, gbase, voff) do { _Pragma("unroll") for (int _i = 0; _i < 2; ++_i) \
        __builtin_amdgcn_global_load_lds((const unsigned*)((const char*)(gbase) + (voff)[_i]), (PG8_LAS unsigned*)(lds + (bufoff) + ldsw + _i * 8192), 16, 0, 0); } while (0)
#define PG8_LDA(dst, b, h) do { _Pragma("unroll") for (int m = 0; m < 4; ++m) _Pragma("unroll") for (int k = 0; k < 2; ++k) dst[m][k] = *(const PG8_LAS bf16x8*)(lds + PG8_SA(b, h) + aoff + m * 2048 + k * 1024); } while (0)
#define PG8_LDB(dst, b, h) do { _Pragma("unroll") for (int n = 0; n < 2; ++n) _Pragma("unroll") for (int k = 0; k < 2; ++k) dst[n][k] = *(const PG8_LAS bf16x8*)(lds + PG8_SB(b, h) + boff + n * 2048 + k * 1024); } while (0)
#define PG8_MMA(ai, bj, At, Bt) do { __builtin_amdgcn_s_setprio(1); _Pragma("unroll") for (int m = 0; m < 4; ++m) _Pragma("unroll") for (int n = 0; n < 2; ++n) _Pragma("unroll") for (int k = 0; k < 2; ++k) \
        acc[ai][bj][m][n] = __builtin_amdgcn_mfma_f32_16x16x32_bf16(Bt[n][k], At[m][k], acc[ai][bj][m][n], 0, 0, 0); __builtin_amdgcn_s_setprio(0); } while (0)
#define PG8_WAIT_V(n) asm volatile("s_waitcnt vmcnt(" #n ")" ::: "memory")
#define PG8_WAIT_L(n) asm volatile("s_waitcnt lgkmcnt(" #n ")" ::: "memory")
#define PG8_BAR __builtin_amdgcn_s_barrier()
#define PG8_SCHED __builtin_amdgcn_sched_barrier(0)
    Unit cur, nxt; int ui = 0;
    if (!S.next(0, cur)) return;
    f32x4 acc[2][2][4][2];
#pragma unroll
    for (int a = 0; a < 2; ++a)
#pragma unroll
        for (int b = 0; b < 2; ++b)
#pragma unroll
            for (int m = 0; m < 4; ++m)
#pragma unroll
                for (int n = 0; n < 2; ++n) acc[a][b][m][n] = (f32x4){0.f, 0.f, 0.f, 0.f};
    bf16x8 At[4][2], B0[2][2], B1[2][2];
    const char* cA = (const char*)g.A + (size_t)cur.pm * tstep; const char* cB = (const char*)g.Bt + (size_t)cur.pn * tstep;
    S.a_ready(cur);
    if constexpr (SP2) {
        PG8_STAGE(PG8_SB(0, 0), cB, voffB); PG8_STAGE(PG8_SB(0, 1), cB + hstep, voffB); PG8_STAGE(PG8_SA(0, 0), cA, voffA); PG8_STAGE(PG8_SA(0, 1), cA + hstep, voffA);
        if (wr == 1) PG8_BAR;
        PG8_WAIT_V(2); PG8_BAR;
        PG8_STAGE(PG8_SB(1, 0), cB + kstep, voffB); PG8_STAGE(PG8_SA(1, 0), cA + kstep, voffA); PG8_STAGE(PG8_SB(1, 1), cB + hstep + kstep, voffB);
        PG8_WAIT_V(6); PG8_BAR;
    } else {
        PG8_STAGE(PG8_SB(0, 0), cB, voffB); PG8_STAGE(PG8_SA(0, 0), cA, voffA); PG8_STAGE(PG8_SB(0, 1), cB + hstep, voffB); PG8_STAGE(PG8_SA(0, 1), cA + hstep, voffA);
        if (wr == 1) PG8_BAR;
        PG8_WAIT_V(4); PG8_BAR;
        PG8_STAGE(PG8_SB(1, 0), cB + kstep, voffB); PG8_STAGE(PG8_SA(1, 0), cA + kstep, voffA); PG8_STAGE(PG8_SB(1, 1), cB + hstep + kstep, voffB);
        PG8_WAIT_V(6); PG8_BAR;
    }
    for (;;) {
        const bool has_next = S.next(ui + 1, nxt);
        const char* nA = has_next ? (const char*)g.A + (size_t)nxt.pm * tstep : cA; const char* nB = has_next ? (const char*)g.Bt + (size_t)nxt.pn * tstep : cB;
        for (int t = 0; t < nt; t += 2) {
            const bool last = (t == nt - 2);
            const char* a1 = cA + (size_t)(t + 1) * kstep;
            const char* a2 = last ? nA : cA + (size_t)(t + 2) * kstep; const char* b2 = last ? nB : cB + (size_t)(t + 2) * kstep;
            const char* a3 = a2 + kstep; const char* b3 = b2 + kstep;
            if (last && has_next) S.a_ready(nxt);
            if constexpr (SP2) {
            PG8_LDB(B0, 0, 0); PG8_LDB(B1, 0, 1); PG8_SCHED; PG8_LDA(At, 0, 0); PG8_STAGE(PG8_SA(1, 1), a1 + hstep, voffA);
            PG8_WAIT_V(8); PG8_WAIT_L(0); PG8_BAR; PG8_MMA(0, 0, At, B0); PG8_MMA(0, 1, At, B1); PG8_BAR; PG8_SCHED;
            PG8_LDA(At, 0, 1); PG8_STAGE(PG8_SB(0, 0), b2, voffB); PG8_STAGE(PG8_SB(0, 1), b2 + hstep, voffB); PG8_STAGE(PG8_SA(0, 0), a2, voffA);
            PG8_WAIT_V(8); PG8_WAIT_L(0); PG8_BAR; PG8_MMA(1, 0, At, B0); PG8_MMA(1, 1, At, B1); PG8_BAR; PG8_SCHED;
            PG8_LDB(B0, 1, 0); PG8_LDB(B1, 1, 1); PG8_SCHED; PG8_LDA(At, 1, 0); PG8_STAGE(PG8_SA(0, 1), a2 + hstep, voffA);
            PG8_WAIT_V(8); PG8_WAIT_L(0); PG8_BAR; PG8_MMA(0, 0, At, B0); PG8_MMA(0, 1, At, B1); PG8_BAR; PG8_SCHED;
            PG8_LDA(At, 1, 1); PG8_STAGE(PG8_SB(1, 0), b3, voffB); PG8_STAGE(PG8_SB(1, 1), b3 + hstep, voffB); PG8_STAGE(PG8_SA(1, 0), a3, voffA);
            PG8_WAIT_V(8); PG8_WAIT_L(0); PG8_BAR; PG8_MMA(1, 0, At, B0); PG8_MMA(1, 1, At, B1); PG8_BAR; PG8_SCHED;
            } else {
            PG8_LDB(B0, 0, 0); PG8_SCHED; PG8_LDA(At, 0, 0); PG8_STAGE(PG8_SA(1, 1), a1 + hstep, voffA);
            PG8_WAIT_L(8); PG8_BAR; PG8_WAIT_L(0); PG8_MMA(0, 0, At, B0); PG8_BAR; PG8_SCHED;
            PG8_LDB(B1, 0, 1); PG8_STAGE(PG8_SB(0, 0), b2, voffB);
            PG8_BAR; PG8_WAIT_L(0); PG8_MMA(0, 1, At, B1); PG8_BAR;
            PG8_LDA(At, 0, 1); PG8_STAGE(PG8_SA(0, 0), a2, voffA);
            PG8_BAR; PG8_WAIT_L(0); PG8_MMA(1, 0, At, B0); PG8_BAR; PG8_SCHED;
            PG8_STAGE(PG8_SB(0, 1), b2 + hstep, voffB);
            PG8_WAIT_V(6); PG8_BAR; PG8_MMA(1, 1, At, B1); PG8_BAR;
            PG8_LDB(B0, 1, 0); PG8_SCHED; PG8_LDA(At, 1, 0); PG8_STAGE(PG8_SA(0, 1), a2 + hstep, voffA);
            PG8_WAIT_L(8); PG8_BAR; PG8_WAIT_L(0); PG8_MMA(0, 0, At, B0); PG8_BAR; PG8_SCHED;
            PG8_LDB(B1, 1, 1); PG8_STAGE(PG8_SB(1, 0), b3, voffB);
            PG8_BAR; PG8_WAIT_L(0); PG8_MMA(0, 1, At, B1); PG8_BAR;
            PG8_LDA(At, 1, 1); PG8_STAGE(PG8_SA(1, 0), a3, voffA);
            PG8_BAR; PG8_WAIT_L(0); PG8_MMA(1, 0, At, B0); PG8_BAR; PG8_SCHED;
            PG8_STAGE(PG8_SB(1, 1), b3 + hstep, voffB);
            PG8_WAIT_V(6); PG8_BAR; PG8_MMA(1, 1, At, B1); PG8_BAR;
            }
        }
        if constexpr (ALIGN_EPI) { if (wr == 0) PG8_BAR; }
        if constexpr (!Epi::AFTER_DRAIN) { E(acc, cur, wr, wc, fr, fq); S.done(cur); }
        if (!has_next) break;
#pragma unroll
        for (int a = 0; a < 2; ++a)
#pragma unroll
            for (int b = 0; b < 2; ++b)
#pragma unroll
                for (int m = 0; m < 4; ++m)
#pragma unroll
                    for (int n = 0; n < 2; ++n) acc[a][b][m][n] = (f32x4){0.f, 0.f, 0.f, 0.f};
        cur = nxt; cA = nA; cB = nB; ++ui;
        if constexpr (ALIGN_EPI) { if (wr == 1) PG8_BAR; }
    }
    PG8_WAIT_V(0);
    if constexpr (!ALIGN_EPI) { if (wr == 0) PG8_BAR; }
    PG8_BAR;
    if constexpr (Epi::AFTER_DRAIN) { E.fused(acc, cur, wr, wc, fr, fq, lds, wid, lane); S.done(cur); }
#undef PG8_SA
#undef PG8_SB
#undef PG8_STAGE
#undef PG8_LDA
#undef PG8_LDB
#undef PG8_MMA
#undef PG8_WAIT_V
#undef PG8_WAIT_L
#undef PG8_BAR
#undef PG8_SCHED
}
}
#define LAS __attribute__((address_space(3)))
typedef unsigned short bf16_t;
typedef short bf16x8 __attribute__((ext_vector_type(8)));
typedef float f32x4 __attribute__((ext_vector_type(4)));
typedef float f32x16 __attribute__((ext_vector_type(16)));
typedef unsigned u32x4 __attribute__((ext_vector_type(4)));
typedef unsigned u32x2 __attribute__((ext_vector_type(2)));
typedef float f32x2_t __attribute__((ext_vector_type(2)));
typedef __bf16 bf16x2_t __attribute__((ext_vector_type(2)));

constexpr int T = 4096, DM = 1024, NBATCH = 16, DEPTH = 2;
#ifndef REP_P0
#define REP_P0 0
#endif
#ifndef REP_SYNC
#define REP_SYNC 0
#endif
#ifndef REP_MISC
#define REP_MISC 0
#endif
#ifndef REP_D2
#define REP_D2 0
#endif
#ifndef REP_B4
#define REP_B4 0
#endif
#ifndef REP_BALL
#define REP_BALL 0
#endif
#ifndef REP_N
#define REP_N 0
#endif
#ifndef REP_A1
#define REP_A1 0
#endif
#ifndef D1_DOUBLE
#define D1_DOUBLE 0
#endif
#ifndef REP_A
#define REP_A 0
#endif
#ifndef REP_C
#define REP_C 0
#endif
#ifndef REP_D1
#define REP_D1 0
#endif
#ifndef REP_B5
#define REP_B5 0
#endif
#ifndef REP_B23
#define REP_B23 0
#endif
#ifndef NGROUP
#define NGROUP 1
#endif
constexpr int NG = NGROUP, GB = NBATCH / NG, MG = GB * T;
constexpr int NP = 3584, NGATE = 4096, NTOT = NP + NGATE;
constexpr int DIN = 7568;
constexpr int C_Q = 0, C_KC = 256, C_VC = 320, C_KS = 384, C_VS = 448, C_KW = 512, C_VW = 576, C_POOL = 640, C_CX = 896, C_CB = 1152, C_CC = 1408,
              C_FQ = 1664, C_FK = 1920, C_FV = 2176, C_GATE = 2432, C_SM = 3456;
constexpr float LOG2E = 1.4426950408889634f;
constexpr float QS = 0.125f * LOG2E;
constexpr float NEG_INF = -INFINITY;

constexpr size_t MiB = 1u << 20;
constexpr size_t WS_CTL = 0;
constexpr size_t WS_TAB = 64 * 1024;
constexpr size_t WS_B1P = WS_TAB + 256 * 1024;
constexpr size_t WS_W2T = WS_B1P + 4096;
constexpr size_t WS_PWT = 512 * 1024;
constexpr size_t WS_W1T = 1 * MiB;
constexpr size_t WS_WBT = 3 * MiB;
constexpr size_t WS_WOT = 7 * MiB;
constexpr size_t WS_WIN = 11 * MiB;
constexpr size_t WS_RSTD = 41 * MiB;
constexpr size_t WS_CFOX = 42 * MiB;
constexpr size_t WS_KC = 43 * MiB;
constexpr size_t WS_VCT = 44 * MiB;
constexpr size_t WS_VT = 45 * MiB;
constexpr size_t SZ_VT = (size_t)6 * GB * 64 * T * 2;
constexpr size_t WS_XB = WS_VT + SZ_VT;
#if NGROUP == 1
constexpr size_t WS_AB = WS_XB;
constexpr size_t WS_PROJ = WS_XB + (size_t)MG * DM * 2;
constexpr size_t WS_TOT = WS_PROJ;
#else
constexpr size_t WS_AB = WS_XB + (size_t)MG * DM * 2;
constexpr size_t WS_TOT = WS_AB + (size_t)MG * DM * 2;
constexpr size_t WS_PROJ = WS_TOT + (size_t)MG * DM * 2;
#endif
constexpr size_t WS_GATES = WS_PROJ + (size_t)MG * NP * 2;
constexpr size_t WS_END = WS_GATES + (size_t)MG * NGATE;
static_assert(WS_END <= (size_t)1024 * MiB, "workspace map exceeds 1 GiB");

constexpr int LDS_BYTES = 147456;
constexpr int AL_K = 0, AL_V = 18432, AL_CK = 36864, AL_U = 37376, AL_KC = 40960, AL_VC = 77824, AL_IMP = 111616, AL_SEL = 128256;

__device__ __forceinline__ float bf2f(unsigned short v) { return __uint_as_float((unsigned)v << 16); }
__device__ __forceinline__ unsigned pk2(float lo, float hi) { f32x2_t v = {lo, hi}; bf16x2_t b = __builtin_convertvector(v, bf16x2_t); return __builtin_bit_cast(unsigned, b); }
__device__ __forceinline__ unsigned short f2bf(float f) { return (unsigned short)(pk2(f, 0.f) & 0xffffu); }
__device__ __forceinline__ float lo16(unsigned w) { return __uint_as_float(w << 16); }
__device__ __forceinline__ float hi16(unsigned w) { return __uint_as_float(w & 0xffff0000u); }
__device__ __forceinline__ float fexp2(float x) { return __builtin_amdgcn_exp2f(x); }
__device__ __forceinline__ float frcp(float x) { return __builtin_amdgcn_rcpf(x); }
__device__ __forceinline__ float sigmoidf_(float x) { return frcp(1.f + fexp2(-x * LOG2E)); }
__device__ __forceinline__ float siluf_(float x) { return x * sigmoidf_(x); }
__device__ __forceinline__ float wave_sum(float v) {
#pragma unroll
  for (int o = 1; o < 64; o <<= 1) v += __shfl_xor(v, o);
  return v;
}
#define LDS_BARRIER() do { asm volatile("s_waitcnt lgkmcnt(0)" ::: "memory"); __builtin_amdgcn_s_barrier(); asm volatile("" ::: "memory"); } while (0)
__device__ __forceinline__ int crow(int r, int hi) { return (r & 3) + 8 * (r >> 2) + 4 * hi; }

struct EpiA {
  static constexpr bool PERM = true, AFTER_DRAIN = false;
  bf16_t* proj; unsigned char* gates;
  __device__ __forceinline__ void operator()(const pg8::f32x4 (&acc)[2][2][4][2], const pg8::Unit& u, int wr, int wc, int fr, int fq) const {
    const int row0 = u.pm * 256 + wr * 64 + fr;
    const bool isg = u.pn >= (NP / 256);
    if (!isg) {
      const int col0 = u.pn * 256 + wc * 32 + 8 * fq;
#pragma unroll
      for (int ai = 0; ai < 2; ++ai)
#pragma unroll
        for (int m = 0; m < 4; ++m) {
          bf16_t* rowp = proj + (size_t)(row0 + ai * 128 + m * 16) * NP + col0;
#pragma unroll
          for (int bj = 0; bj < 2; ++bj) {
            const pg8::f32x4 v0 = acc[ai][bj][m][0], v1 = acc[ai][bj][m][1];
            u32x4 w; w.x = pk2(v0[0], v0[1]); w.y = pk2(v0[2], v0[3]); w.z = pk2(v1[0], v1[1]); w.w = pk2(v1[2], v1[3]);
            *(u32x4*)(rowp + bj * 128) = w;
          }
        }
    } else {
      const int col0 = (u.pn - NP / 256) * 256 + wc * 32 + 8 * fq;
#pragma unroll
      for (int ai = 0; ai < 2; ++ai)
#pragma unroll
        for (int m = 0; m < 4; ++m) {
          unsigned char* rowp = gates + (size_t)(row0 + ai * 128 + m * 16) * NGATE + col0;
#pragma unroll
          for (int bj = 0; bj < 2; ++bj) {
            const pg8::f32x4 v0 = acc[ai][bj][m][0], v1 = acc[ai][bj][m][1];
            u32x2 w; w.x = 0u; w.y = 0u;
#pragma unroll
            for (int e = 0; e < 4; ++e) {
              w.x = __builtin_amdgcn_cvt_pk_u8_f32(sigmoidf_(v0[e]) * 255.0f, e, w.x);
              w.y = __builtin_amdgcn_cvt_pk_u8_f32(sigmoidf_(v1[e]) * 255.0f, e, w.y);
            }
            *(u32x2*)(rowp + bj * 128) = w;
          }
        }
    }
  }
};
struct EpiD2 {
  static constexpr bool PERM = true, AFTER_DRAIN = false;
  const float* xin; float* xout;
  __device__ __forceinline__ void operator()(const pg8::f32x4 (&acc)[2][2][4][2], const pg8::Unit& u, int wr, int wc, int fr, int fq) const {
    const int row0 = u.pm * 256 + wr * 64 + fr, col0 = u.pn * 256 + wc * 32 + 8 * fq;
#pragma unroll
    for (int ai = 0; ai < 2; ++ai)
#pragma unroll
      for (int m = 0; m < 4; ++m) {
        const size_t off = (size_t)(row0 + ai * 128 + m * 16) * 1024 + col0;
#pragma unroll
        for (int bj = 0; bj < 2; ++bj) {
          const pg8::f32x4 x0 = *(const pg8::f32x4*)(xin + off + bj * 128), x1 = *(const pg8::f32x4*)(xin + off + bj * 128 + 4);
          *(pg8::f32x4*)(xout + off + bj * 128) = x0 + acc[ai][bj][m][0];
          *(pg8::f32x4*)(xout + off + bj * 128 + 4) = x1 + acc[ai][bj][m][1];
        }
        asm volatile("" ::: "memory");
      }
  }
};
struct Args {
  const float* x; const float* norm_g; const float* w_in; const float* fox_f_bias; const float* cmp_pos; const float* cmp_w1; const float* cmp_b1;
  const float* cmp_w2; const float* cmp_b2; const float* pool_w; const float* pool_scale; const float* conv_w; const float* w_branch; const float* w_out;
  const float* final_g; float* out; unsigned char* ws;
};

__device__ __forceinline__ int win_srccol(int n) {
  if (n < 640) return n;
  if (n < 2432) return n + 12;
  if (n < 3456) return n + 16;
  if (n < 3468) return 640 + (n - 3456);
  if (n < 3472) return 2444 + (n - 3468);
  if (n < NP) return -1;
  return 3472 + (n - NP);
}

__device__ __forceinline__ void p0_prologue(const Args& a, int gt, int ngt) {
  unsigned char* ws = a.ws;
  {
    bf16_t* dst = (bf16_t*)(ws + WS_WIN);
    const int total = DEPTH * NTOT * (DM / 8);
    for (int it = gt; it < total; it += ngt) {
      const int n = it % NTOT, r = it / NTOT, kc = r % (DM / 8), l = r / (DM / 8);
      const int sc = win_srccol(n);
      const float qs = (n < 256 || (n >= C_FQ && n < C_FQ + 256)) ? QS : 1.f;
      float v[8];
#pragma unroll
      for (int j = 0; j < 8; ++j) { const int k = kc * 8 + j; v[j] = (sc < 0) ? 0.f : a.w_in[((size_t)l * DM + k) * DIN + sc] * a.norm_g[l * DM + k] * qs; }
      u32x4 w; w.x = pk2(v[0], v[1]); w.y = pk2(v[2], v[3]); w.z = pk2(v[4], v[5]); w.w = pk2(v[6], v[7]);
      *(u32x4*)(dst + ((size_t)l * NTOT + n) * DM + kc * 8) = w;
    }
  }
  {
    bf16_t* dst = (bf16_t*)(ws + WS_WBT);
    const int total = 8 * 1024 * 32;
    for (int it = gt; it < total; it += ngt) {
      const int n = it % 1024, r = it / 1024, kc = r % 32, mi = r / 32;
      const float* src = a.w_branch + (size_t)mi * 256 * 1024;
      float v[8];
#pragma unroll
      for (int j = 0; j < 8; ++j) v[j] = src[(size_t)(kc * 8 + j) * 1024 + n];
      u32x4 w; w.x = pk2(v[0], v[1]); w.y = pk2(v[2], v[3]); w.z = pk2(v[4], v[5]); w.w = pk2(v[6], v[7]);
      *(u32x4*)(dst + ((size_t)mi * 1024 + n) * 256 + kc * 8) = w;
    }
  }
  {
    bf16_t* dst = (bf16_t*)(ws + WS_WOT);
    const int total = 2 * 1024 * 128;
    for (int it = gt; it < total; it += ngt) {
      const int n = it % 1024, r = it / 1024, kc = r % 128, l = r / 128;
      const float* src = a.w_out + (size_t)l * 1024 * 1024;
      float v[8];
#pragma unroll
      for (int j = 0; j < 8; ++j) v[j] = src[(size_t)(kc * 8 + j) * 1024 + n] * (1.0f / 255.0f);
      u32x4 w; w.x = pk2(v[0], v[1]); w.y = pk2(v[2], v[3]); w.z = pk2(v[4], v[5]); w.w = pk2(v[6], v[7]);
      *(u32x4*)(dst + ((size_t)l * 1024 + n) * 1024 + kc * 8) = w;
    }
  }
  {
    bf16_t* dst = (bf16_t*)(ws + WS_W1T);
    const int total = 4 * 128 * 256;
    for (int it = gt; it < total; it += ngt) {
      const int c = it % 128, r = it / 128, kc = r % 256, m4 = r / 256;
      const float* src = a.cmp_w1 + (size_t)m4 * 2048 * 128;
      float v[8];
#pragma unroll
      for (int j = 0; j < 8; ++j) v[j] = src[(size_t)(kc * 8 + j) * 128 + c];
      u32x4 w; w.x = pk2(v[0], v[1]); w.y = pk2(v[2], v[3]); w.z = pk2(v[4], v[5]); w.w = pk2(v[6], v[7]);
      *(u32x4*)(dst + ((size_t)m4 * 128 + c) * 2048 + kc * 8) = w;
    }
  }
  {
    bf16_t* dst = (bf16_t*)(ws + WS_W2T);
    const int total = 4 * 64 * 16;
    for (int it = gt; it < total; it += ngt) {
      const int d = it % 64, r = it / 64, kc = r % 16, m4 = r / 16;
      const float* src = a.cmp_w2 + (size_t)m4 * 128 * 64;
      float v[8];
#pragma unroll
      for (int j = 0; j < 8; ++j) v[j] = src[(size_t)(kc * 8 + j) * 64 + d];
      u32x4 w; w.x = pk2(v[0], v[1]); w.y = pk2(v[2], v[3]); w.z = pk2(v[4], v[5]); w.w = pk2(v[6], v[7]);
      *(u32x4*)(dst + ((size_t)m4 * 64 + d) * 128 + kc * 8) = w;
    }
  }
  {
    bf16_t* dst = (bf16_t*)(ws + WS_PWT);
    const int total = 8 * 64 * 8;
    for (int it = gt; it < total; it += ngt) {
      const int d = it % 64, r = it / 64, kc = r % 8, lg = r / 8;
      const float* src = a.pool_w + (size_t)lg * 4096;
      float v[8];
#pragma unroll
      for (int j = 0; j < 8; ++j) v[j] = src[(size_t)(kc * 8 + j) * 64 + d];
      u32x4 w; w.x = pk2(v[0], v[1]); w.y = pk2(v[2], v[3]); w.z = pk2(v[4], v[5]); w.w = pk2(v[6], v[7]);
      *(u32x4*)(dst + ((size_t)lg * 64 + d) * 64 + kc * 8) = w;
    }
  }
  {
    float* dst = (float*)(ws + WS_B1P);
    const int gw = gt >> 6, ngw = ngt >> 6, lane = gt & 63;
    for (int o = gw; o < 512; o += ngw) {
      const int c = o % 128, m4 = o / 128;
      const float* w1 = a.cmp_w1 + (size_t)m4 * 2048 * 128; const float* pos = a.cmp_pos + (size_t)m4 * 2048;
      float s = 0.f;
      for (int kk = lane; kk < 2048; kk += 64) s += pos[kk] * w1[(size_t)kk * 128 + c];
      s = wave_sum(s);
      if (lane == 0) dst[o] = s + a.cmp_b1[m4 * 128 + c];
    }
  }
  {
    float* tab = (float*)(ws + WS_TAB);
    for (int it = gt; it < T * 8; it += ngt) {
      const int i = it & 7, t = it >> 3;
      const float inv = powf(500000.0f, -(float)i / 8.0f);
      const float ang = (float)t * inv;
      double rev = (double)ang * 0.15915494309189535; rev -= rint(rev);
      const float rv = (float)rev;
      tab[it * 2] = __builtin_amdgcn_cosf(rv); tab[it * 2 + 1] = __builtin_amdgcn_sinf(rv);
    }
  }
  if (gt < 64) ((unsigned*)(ws + WS_CTL))[gt] = 0u;
}

__device__ __forceinline__ void phase_rows(const float* __restrict__ xin, bf16_t* __restrict__ xb, float* rstd, int M, int gw, int ngw, int lane) {
  (void)rstd;
  for (int m0 = gw * 4; m0 < M; m0 += ngw * 4) {
    f32x4 v[4][4];
#pragma unroll
    for (int r = 0; r < 4; ++r) { const f32x4* xr = (const f32x4*)(xin + (size_t)(m0 + r) * DM) + lane;
#pragma unroll
      for (int j = 0; j < 4; ++j) v[r][j] = xr[64 * j]; }
#pragma unroll
    for (int r = 0; r < 4; ++r) {
      float s = 0.f;
#pragma unroll
      for (int j = 0; j < 4; ++j) s += (v[r][j].x * v[r][j].x + v[r][j].y * v[r][j].y) + (v[r][j].z * v[r][j].z + v[r][j].w * v[r][j].w);
      s = wave_sum(s);
      const float rs = 1.0f / sqrtf(s * (1.f / DM) + 1e-6f);
      u32x2* o = (u32x2*)(xb + (size_t)(m0 + r) * DM) + lane;
#pragma unroll
      for (int j = 0; j < 4; ++j) { u32x2 w; w.x = pk2(v[r][j].x * rs, v[r][j].y * rs); w.y = pk2(v[r][j].z * rs, v[r][j].w * rs); o[64 * j] = w; }
    }
  }
}
__device__ __forceinline__ void phase_final_norm(float* xio, const float* __restrict__ g, int M, int gw, int ngw, int lane) {
  f32x4 gg[4];
#pragma unroll
  for (int j = 0; j < 4; ++j) gg[j] = ((const f32x4*)g)[64 * j + lane];
  for (int m0 = gw * 4; m0 < M; m0 += ngw * 4) {
    f32x4 v[4][4];
#pragma unroll
    for (int r = 0; r < 4; ++r) { const f32x4* xr = (const f32x4*)(xio + (size_t)(m0 + r) * DM) + lane;
#pragma unroll
      for (int j = 0; j < 4; ++j) v[r][j] = xr[64 * j]; }
#pragma unroll
    for (int r = 0; r < 4; ++r) {
      float s = 0.f;
#pragma unroll
      for (int j = 0; j < 4; ++j) s += (v[r][j].x * v[r][j].x + v[r][j].y * v[r][j].y) + (v[r][j].z * v[r][j].z + v[r][j].w * v[r][j].w);
      s = wave_sum(s);
      const float rs = 1.0f / sqrtf(s * (1.f / DM) + 1e-6f);
      f32x4* xr = (f32x4*)(xio + (size_t)(m0 + r) * DM) + lane;
#pragma unroll
      for (int j = 0; j < 4; ++j) xr[64 * j] = v[r][j] * rs * gg[j];
    }
  }
}

__device__ __forceinline__ void b1_rope(bf16_t* proj, const float* tab, int gt, int ngt) {
  const int total = MG * 8;
  for (int it = gt; it < total; it += ngt) {
    const int tok = it >> 3, slot = it & 7; if (slot >= 6) continue;
    const int col = (slot < 4 ? C_Q + slot * 64 : (slot == 4 ? C_KS : C_KW));
    const int t = tok & (T - 1);
    u32x4* p = (u32x4*)(proj + (size_t)tok * NP + col);
    const u32x4 a = p[0], b = p[1];
    const f32x4* tb = (const f32x4*)(tab + (size_t)t * 16);
    const f32x4 t0 = tb[0], t1 = tb[1], t2 = tb[2], t3 = tb[3];
    const float x1[8] = {lo16(a.x), hi16(a.x), lo16(a.y), hi16(a.y), lo16(a.z), hi16(a.z), lo16(a.w), hi16(a.w)};
    const float x2[8] = {lo16(b.x), hi16(b.x), lo16(b.y), hi16(b.y), lo16(b.z), hi16(b.z), lo16(b.w), hi16(b.w)};
    const float cs[8] = {t0.x, t0.z, t1.x, t1.z, t2.x, t2.z, t3.x, t3.z}, sn[8] = {t0.y, t0.w, t1.y, t1.w, t2.y, t2.w, t3.y, t3.w};
    float y1[8], y2[8];
#pragma unroll
    for (int i = 0; i < 8; ++i) { y1[i] = x1[i] * cs[i] - x2[i] * sn[i]; y2[i] = x2[i] * cs[i] + x1[i] * sn[i]; }
    u32x4 oa, ob; oa.x = pk2(y1[0], y1[1]); oa.y = pk2(y1[2], y1[3]); oa.z = pk2(y1[4], y1[5]); oa.w = pk2(y1[6], y1[7]);
    ob.x = pk2(y2[0], y2[1]); ob.y = pk2(y2[2], y2[3]); ob.z = pk2(y2[4], y2[5]); ob.w = pk2(y2[6], y2[7]);
    p[0] = oa; p[1] = ob;
  }
}
__device__ __forceinline__ void b2_vtrans(const bf16_t* __restrict__ proj, bf16_t* __restrict__ vt, LAS unsigned char* lds, int gw, int ngw, int wid, int lane) {
  (void)lds; (void)wid;
  const int dblk = lane & 7, tblk = lane >> 3;
  const int total = 6 * GB * 64;
#pragma unroll 2
  for (int it = gw; it < total; it += ngw) {
    const int tt = it & 63, r = it >> 6, b = r % GB, src = r / GB;
    const int col = (src == 0) ? C_VS : (src == 1 ? C_VW : C_FV + (src - 2) * 64);
    const bf16_t* g = proj + (size_t)(b * T + tt * 64 + tblk * 8) * NP + col + dblk * 8;
    u32x4 a[8];
#pragma unroll
    for (int rr = 0; rr < 8; ++rr) a[rr] = *(const u32x4*)(g + (size_t)rr * NP);
    bf16_t* o = vt + ((size_t)(src * GB + b) * 64 + dblk * 8) * T + tt * 64 + tblk * 8;
#pragma unroll
    for (int i = 0; i < 8; ++i) {
      u32x4 w;
#pragma unroll
      for (int k = 0; k < 4; ++k) {
        const unsigned lo = a[2 * k][i >> 1], hi = a[2 * k + 1][i >> 1];
        w[k] = (i & 1) ? ((lo >> 16) | (hi & 0xffff0000u)) : ((lo & 0xffffu) | (hi << 16));
      }
      *(u32x4*)(o + (size_t)i * T) = w;
    }
  }
}
__device__ __forceinline__ float logsig(float z) { return fminf(z, 0.f) - __builtin_amdgcn_logf(1.f + fexp2(-fabsf(z) * LOG2E)) * 0.6931471805599453f; }
__device__ __forceinline__ void b3_foxcum(const bf16_t* proj, const float* fbias, float* c2, LAS unsigned char* lds, int tid, int wid, int lane) {
  LAS float* wtot = (LAS float*)(lds + 140 * 1024);
  const float b0 = fbias[0], b1 = fbias[1], b2 = fbias[2], b3 = fbias[3];
  for (int bb = (int)(gridDim.x - 1 - blockIdx.x); bb < GB; bb += gridDim.x) {
    const bf16_t* p = proj + (size_t)(bb * T + tid * 8) * NP + C_SM + 12;
    u32x2 raw[8];
#pragma unroll
    for (int j = 0; j < 8; ++j) raw[j] = *(const u32x2*)(p + (size_t)j * NP);
    float v[8][4]; float s[4] = {0.f, 0.f, 0.f, 0.f};
#pragma unroll
    for (int j = 0; j < 8; ++j) {
      s[0] += logsig(lo16(raw[j].x) + b0); v[j][0] = s[0];
      s[1] += logsig(hi16(raw[j].x) + b1); v[j][1] = s[1];
      s[2] += logsig(lo16(raw[j].y) + b2); v[j][2] = s[2];
      s[3] += logsig(hi16(raw[j].y) + b3); v[j][3] = s[3];
    }
    float incl[4];
#pragma unroll
    for (int h = 0; h < 4; ++h) {
      float x = s[h];
#pragma unroll
      for (int o = 1; o < 64; o <<= 1) { const float y = __shfl_up(x, o); if (lane >= o) x += y; }
      incl[h] = x;
      if (lane == 63) wtot[wid * 4 + h] = x;
    }
    __syncthreads();
#pragma unroll
    for (int h = 0; h < 4; ++h) {
      float pre = incl[h] - s[h];
      for (int w = 0; w < wid; ++w) pre += wtot[w * 4 + h];
      float* o = c2 + (size_t)(bb * 4 + h) * T + tid * 8;
      f32x4 o0, o1;
      o0.x = (pre + v[0][h]) * LOG2E; o0.y = (pre + v[1][h]) * LOG2E; o0.z = (pre + v[2][h]) * LOG2E; o0.w = (pre + v[3][h]) * LOG2E;
      o1.x = (pre + v[4][h]) * LOG2E; o1.y = (pre + v[5][h]) * LOG2E; o1.z = (pre + v[6][h]) * LOG2E; o1.w = (pre + v[7][h]) * LOG2E;
      *(f32x4*)o = o0; *(f32x4*)(o + 4) = o1;
    }
    __syncthreads();
  }
}
__device__ __forceinline__ void b7_knorm(const bf16_t* __restrict__ proj, float* __restrict__ kn, int gw, int ngw, int lane) {
  const int total = GB * 4 * 64;
  for (int it = gw; it < total; it += ngw) {
    const int j = it & 63, h = (it >> 6) & 3, b = it >> 8;
    const u32x4* p = (const u32x4*)(proj + (size_t)(b * T + j * 64 + lane) * NP + C_FK + h * 64);
    float ss = 0.f;
#pragma unroll
    for (int c = 0; c < 8; ++c) { const u32x4 v = p[c];
      const float f[8] = {lo16(v.x), hi16(v.x), lo16(v.y), hi16(v.y), lo16(v.z), hi16(v.z), lo16(v.w), hi16(v.w)};
#pragma unroll
      for (int e = 0; e < 8; ++e) ss += f[e] * f[e]; }
#pragma unroll
    for (int o = 1; o < 64; o <<= 1) ss = fmaxf(ss, __shfl_xor(ss, o));
    if (lane == 0) kn[it] = sqrtf(ss) * 1.001f;
  }
}
__device__ __forceinline__ void b4_compress(const bf16_t* proj, const bf16_t* w1T, const bf16_t* w2T, const float* b1p, const float* b2, const float* tab,
                                            bf16_t* kc, bf16_t* vcT, LAS unsigned char* lds, int tid, int wid, int lane) {
  const int r32 = lane & 31, hi = lane >> 5;
  LAS float* hid = (LAS float*)lds;
  LAS bf16_t* hb = (LAS bf16_t*)(lds + 2 * 32 * 132 * 4);
  LAS float* ost = (LAS float*)(lds + 2 * 32 * 132 * 4 + 32 * 136 * 2);
  for (int un = blockIdx.x; un < GB * 16; un += gridDim.x) {
    const int rt = un & 7, kv = (un >> 3) & 1, b = un >> 4;
    const int ct = wid & 3, kh = wid >> 2;
    const int n = rt * 32 + r32;
    const bf16_t* arow = proj + (size_t)(b * T + 16 * n) * NP + (kv ? C_VC : C_KC);
    const bf16_t* brow = w1T + ((size_t)kv * 128 + ct * 32 + r32) * 2048;
    f32x16 acc = {};
#pragma unroll 1
    for (int ks0 = 0; ks0 < 64; ks0 += 8) {
      bf16x8 af[8], bfr[8];
#pragma unroll
      for (int u = 0; u < 8; ++u) {
        const int kk = kh * 1024 + (ks0 + u) * 16 + hi * 8;
        af[u] = bf16x8{};
        if (n < 255) af[u] = *(const bf16x8*)(arow + (size_t)(kk >> 6) * NP + (kk & 63));
        bfr[u] = *(const bf16x8*)(brow + kk);
      }
#pragma unroll
      for (int u = 0; u < 8; ++u) acc = __builtin_amdgcn_mfma_f32_32x32x16_bf16(af[u], bfr[u], acc, 0, 0, 0);
    }
#pragma unroll
    for (int r = 0; r < 16; ++r) hid[(kh * 32 + crow(r, hi)) * 132 + ct * 32 + r32] = acc[r];
    __syncthreads();
    for (int e = tid; e < 32 * 128; e += 512) { const int rr = e >> 7, c = e & 127;
      const float v = hid[rr * 132 + c] + hid[(32 + rr) * 132 + c] + b1p[kv * 128 + c];
      hb[rr * 136 + c] = f2bf(siluf_(v)); }
    __syncthreads();
    if (wid < 2) {
      const int dt = wid; f32x16 a2 = {};
#pragma unroll
      for (int k0 = 0; k0 < 8; ++k0) {
        const bf16x8 af = *(const LAS bf16x8*)(hb + r32 * 136 + k0 * 16 + hi * 8);
        const bf16x8 bf = *(const bf16x8*)(w2T + ((size_t)kv * 64 + dt * 32 + r32) * 128 + k0 * 16 + hi * 8);
        a2 = __builtin_amdgcn_mfma_f32_32x32x16_bf16(af, bf, a2, 0, 0, 0);
      }
      const float bb = b2[kv * 64 + dt * 32 + r32];
#pragma unroll
      for (int r = 0; r < 16; ++r) ost[crow(r, hi) * 65 + dt * 32 + r32] = a2[r] + bb;
    }
    __syncthreads();
    for (int e = tid; e < 32 * 64; e += 512) {
      if (kv == 0) { const int rr = e >> 6, d = e & 63; const int nn = rt * 32 + rr; float v = ost[rr * 65 + d];
        if (d < 16) { const int i = d & 7, pos = 16 * nn + 31; const int pc = pos < T ? pos : T - 1;
          const float c = tab[(pc * 8 + i) * 2], s = tab[(pc * 8 + i) * 2 + 1];
          const float x1 = ost[rr * 65 + i], x2 = ost[rr * 65 + i + 8];
          v = (d < 8) ? (x1 * c - x2 * s) : (x2 * c + x1 * s); }
        if (nn >= 255) v = 0.f;
        kc[((size_t)b * 256 + nn) * 64 + d] = f2bf(v);
      } else { const int d = e >> 5, rr = e & 31; const int nn = rt * 32 + rr; float v = ost[rr * 65 + d]; if (nn >= 255) v = 0.f;
        vcT[((size_t)b * 64 + d) * 256 + nn] = f2bf(v); }
    }
    __syncthreads();
  }
}
__device__ __forceinline__ void b5_pool(const bf16_t* proj, const float* pool_w, const float* pool_scale, bf16_t* ab1, LAS unsigned char* lds, int tid) {
  LAS float* pl = (LAS float*)lds;
  for (int un = blockIdx.x; un < MG / 32; un += gridDim.x) {
    const int tl = tid >> 4, cg16 = tid & 15, tok = un * 32 + tl, t = tok & (T - 1);
    {
      const int c0 = cg16 * 16, gi = c0 >> 6, w = 2 << gi; const int cnt = (t + 1 < w) ? t + 1 : w;
      float s[16];
#pragma unroll
      for (int j = 0; j < 16; ++j) s[j] = 0.f;
      float u0[16];
      for (int k = 0; k < cnt; ++k) {
        const u32x4* p = (const u32x4*)(proj + (size_t)(tok - k) * NP + C_POOL + c0);
        const u32x4 a = p[0], b = p[1];
        const float v[16] = {lo16(a.x), hi16(a.x), lo16(a.y), hi16(a.y), lo16(a.z), hi16(a.z), lo16(a.w), hi16(a.w),
                             lo16(b.x), hi16(b.x), lo16(b.y), hi16(b.y), lo16(b.z), hi16(b.z), lo16(b.w), hi16(b.w)};
#pragma unroll
        for (int j = 0; j < 16; ++j) { s[j] += v[j]; if (k == 0) u0[j] = v[j]; }
      }
      const float ic = 1.0f / (float)cnt;
#pragma unroll
      for (int j = 0; j < 16; ++j) pl[tl * 260 + c0 + j] = s[j] * ic - u0[j];
    }
    __syncthreads();
    {
      const int gi = cg16 >> 2, d0 = (cg16 & 3) * 16;
      float o[16];
#pragma unroll
      for (int j = 0; j < 16; ++j) o[j] = 0.f;
      const float* wp = pool_w + (size_t)gi * 4096 + d0;
      for (int c = 0; c < 64; ++c) {
        const float pv = pl[tl * 260 + gi * 64 + c];
        const f32x4* w4 = (const f32x4*)(wp + c * 64);
#pragma unroll
        for (int q = 0; q < 4; ++q) { const f32x4 ww = w4[q]; o[4 * q] += pv * ww.x; o[4 * q + 1] += pv * ww.y; o[4 * q + 2] += pv * ww.z; o[4 * q + 3] += pv * ww.w; }
      }
      const int ch = gi * 64 + d0;
      const u32x4* gp = (const u32x4*)(proj + (size_t)tok * NP + C_GATE + 256 + ch);
      const u32x4 ga = gp[0], gb = gp[1];
      const float gv[16] = {lo16(ga.x), hi16(ga.x), lo16(ga.y), hi16(ga.y), lo16(ga.z), hi16(ga.z), lo16(ga.w), hi16(ga.w),
                            lo16(gb.x), hi16(gb.x), lo16(gb.y), hi16(gb.y), lo16(gb.z), hi16(gb.z), lo16(gb.w), hi16(gb.w)};
      float r[16];
#pragma unroll
      for (int j = 0; j < 16; ++j) r[j] = o[j] * pool_scale[ch + j] * siluf_(gv[j]);
      u32x4 w0, w1; w0.x = pk2(r[0], r[1]); w0.y = pk2(r[2], r[3]); w0.z = pk2(r[4], r[5]); w0.w = pk2(r[6], r[7]);
      w1.x = pk2(r[8], r[9]); w1.y = pk2(r[10], r[11]); w1.z = pk2(r[12], r[13]); w1.w = pk2(r[14], r[15]);
      u32x4* op = (u32x4*)(ab1 + (size_t)tok * 256 + ch); op[0] = w0; op[1] = w1;
    }
    __syncthreads();
  }
}
template <int W>
__device__ __forceinline__ void pool_window(const bf16_t* p, int t, float (&s)[8], float (&u0)[8]) {
  u32x4 v[W];
#pragma unroll
  for (int k = 0; k < W; ++k) v[k] = (k <= t) ? *(const u32x4*)(p - (size_t)k * NP) : u32x4{0u, 0u, 0u, 0u};
#pragma unroll
  for (int j = 0; j < 8; ++j) s[j] = 0.f;
#pragma unroll
  for (int k = 0; k < W; ++k) {
    const float f[8] = {lo16(v[k].x), hi16(v[k].x), lo16(v[k].y), hi16(v[k].y), lo16(v[k].z), hi16(v[k].z), lo16(v[k].w), hi16(v[k].w)};
#pragma unroll
    for (int j = 0; j < 8; ++j) { s[j] += f[j]; if (k == 0) u0[j] = f[j]; }
  }
}
__device__ __forceinline__ void b5_pool_mfma(const bf16_t* __restrict__ proj, const bf16_t* __restrict__ pwT, const float* __restrict__ pool_scale, bf16_t* __restrict__ ab1, int wid, int lane) {
  const int r32 = lane & 31, hi = lane >> 5, gi = wid & 3, th = wid >> 2, w = 2 << gi;
  bf16x8 wf[2][4];
#pragma unroll
  for (int dt = 0; dt < 2; ++dt)
#pragma unroll
    for (int k0 = 0; k0 < 4; ++k0) wf[dt][k0] = *(const bf16x8*)(pwT + ((size_t)gi * 64 + dt * 32 + r32) * 64 + k0 * 16 + hi * 8);
  for (int un = blockIdx.x; un < MG / 64; un += gridDim.x) {
    const int tok = un * 64 + th * 32 + r32, t = tok & (T - 1);
    const int cnt = (t + 1 < w) ? t + 1 : w; const float ic = 1.0f / (float)cnt;
    bf16x8 pf[4];
#pragma unroll
    for (int k0 = 0; k0 < 4; ++k0) {
      const bf16_t* p = proj + (size_t)tok * NP + C_POOL + gi * 64 + k0 * 16 + hi * 8;
      float s[8], u0[8];
      if (gi == 0) pool_window<2>(p, t, s, u0); else if (gi == 1) pool_window<4>(p, t, s, u0); else if (gi == 2) pool_window<8>(p, t, s, u0); else pool_window<16>(p, t, s, u0);
      u32x4 pw; pw.x = pk2(s[0] * ic - u0[0], s[1] * ic - u0[1]); pw.y = pk2(s[2] * ic - u0[2], s[3] * ic - u0[3]);
      pw.z = pk2(s[4] * ic - u0[4], s[5] * ic - u0[5]); pw.w = pk2(s[6] * ic - u0[6], s[7] * ic - u0[7]);
      pf[k0] = __builtin_bit_cast(bf16x8, pw);
    }
    f32x16 acc[2]; acc[0] = f32x16{}; acc[1] = f32x16{};
#pragma unroll
    for (int dt = 0; dt < 2; ++dt)
#pragma unroll
      for (int k0 = 0; k0 < 4; ++k0) acc[dt] = __builtin_amdgcn_mfma_f32_32x32x16_bf16(wf[dt][k0], pf[k0], acc[dt], 0, 0, 0);
#pragma unroll
    for (int dt = 0; dt < 2; ++dt)
#pragma unroll
      for (int g = 0; g < 4; ++g) {
        const int ch = gi * 64 + 32 * dt + 8 * g + 4 * hi;
        const u32x2 gw = *(const u32x2*)(proj + (size_t)tok * NP + C_GATE + 256 + ch);
        const f32x4 sc = *(const f32x4*)(pool_scale + ch);
        const float v0 = acc[dt][4 * g] * sc.x * siluf_(lo16(gw.x)), v1 = acc[dt][4 * g + 1] * sc.y * siluf_(hi16(gw.x));
        const float v2 = acc[dt][4 * g + 2] * sc.z * siluf_(lo16(gw.y)), v3 = acc[dt][4 * g + 3] * sc.w * siluf_(hi16(gw.y));
        u32x2 o; o.x = pk2(v0, v1); o.y = pk2(v2, v3); *(u32x2*)(ab1 + (size_t)tok * 256 + ch) = o;
      }
  }
}
__device__ __forceinline__ void b6_conv(const bf16_t* __restrict__ proj, const float* __restrict__ conv_w, bf16_t* __restrict__ ab2, int gt, int ngt) {
  const int total = MG * 32;
#pragma unroll 2
  for (int it = gt; it < total; it += ngt) {
    const int tok = it >> 5, c0 = (it & 31) * 8, t = tok & (T - 1);
    float y[8];
#pragma unroll
    for (int j = 0; j < 8; ++j) y[j] = 0.f;
#pragma unroll
    for (int k = 0; k < 3; ++k) {
      const int dt = 2 - k;
      if (t - dt >= 0) {
        const bf16_t* rp = proj + (size_t)(tok - dt) * NP;
        const u32x4 xv = *(const u32x4*)(rp + C_CX + c0), cv = *(const u32x4*)(rp + C_CC + c0);
        const float xs[8] = {lo16(xv.x), hi16(xv.x), lo16(xv.y), hi16(xv.y), lo16(xv.z), hi16(xv.z), lo16(xv.w), hi16(xv.w)};
        const float cs[8] = {lo16(cv.x), hi16(cv.x), lo16(cv.y), hi16(cv.y), lo16(cv.z), hi16(cv.z), lo16(cv.w), hi16(cv.w)};
#pragma unroll
        for (int j = 0; j < 8; ++j) y[j] += cs[j] * xs[j] * conv_w[k * 256 + c0 + j];
      }
    }
    const bf16_t* rp = proj + (size_t)tok * NP;
    const u32x4 bv = *(const u32x4*)(rp + C_CB + c0), gv = *(const u32x4*)(rp + C_GATE + 512 + c0);
    const float bs[8] = {lo16(bv.x), hi16(bv.x), lo16(bv.y), hi16(bv.y), lo16(bv.z), hi16(bv.z), lo16(bv.w), hi16(bv.w)};
    const float gs[8] = {lo16(gv.x), hi16(gv.x), lo16(gv.y), hi16(gv.y), lo16(gv.z), hi16(gv.z), lo16(gv.w), hi16(gv.w)};
    float r[8];
#pragma unroll
    for (int j = 0; j < 8; ++j) r[j] = bs[j] * y[j] * siluf_(gs[j]);
    u32x4 w; w.x = pk2(r[0], r[1]); w.y = pk2(r[2], r[3]); w.z = pk2(r[4], r[5]); w.w = pk2(r[6], r[7]);
    *(u32x4*)(ab2 + (size_t)tok * 256 + c0) = w;
  }
}
struct TileRegs { u32x4 k, v; float c; };
template <int MODE>
__device__ __forceinline__ void tile_load(TileRegs& R, const bf16_t* Kg, int kpitch, const bf16_t* Vtg, const float* cgl, int j, int tid) {
  const int row = tid >> 3, ch = tid & 7;
  R.k = *(const u32x4*)(Kg + (size_t)(64 * j + row) * kpitch + ch * 8);
  R.v = *(const u32x4*)(Vtg + (size_t)row * T + 64 * j + ch * 8);
  if (MODE == 0) { if (tid < 64) R.c = cgl[64 * j + tid]; }
}
template <int MODE>
__device__ __forceinline__ void tile_store(const TileRegs& R, LAS unsigned char* lds, int buf, int tid) {
  const int row = tid >> 3, ch = tid & 7;
  *(LAS u32x4*)(lds + AL_K + buf * 9216 + row * 144 + ch * 16) = R.k;
  *(LAS u32x4*)(lds + AL_V + buf * 9216 + row * 144 + ch * 16) = R.v;
  if (MODE == 0) { if (tid < 64) *(LAS float*)(lds + AL_CK + buf * 256 + tid * 4) = R.c; }
}
struct SoftState { float m, l; f32x16 o[2]; };
template <bool OFF = false>
__device__ __forceinline__ void softmax_pv(f32x16& s0, f32x16& s1, SoftState& st, const LAS unsigned char* Vt, int vstride, int kvoff, int r32, int hi) {
  float ra = __builtin_fmaxf(__builtin_fmaxf(s0[0], s0[1]), s1[0]), rb = __builtin_fmaxf(__builtin_fmaxf(s0[2], s0[3]), s1[1]);
  ra = __builtin_fmaxf(__builtin_fmaxf(ra, s1[2]), s1[3]);
#pragma unroll
  for (int r = 4; r < 16; r += 4) {
    ra = __builtin_fmaxf(__builtin_fmaxf(ra, s0[r]), s0[r + 1]); rb = __builtin_fmaxf(__builtin_fmaxf(rb, s0[r + 2]), s0[r + 3]);
    ra = __builtin_fmaxf(__builtin_fmaxf(ra, s1[r]), s1[r + 1]); rb = __builtin_fmaxf(__builtin_fmaxf(rb, s1[r + 2]), s1[r + 3]);
  }
  float rm = __builtin_fmaxf(ra, rb);
  rm = __builtin_fmaxf(rm, __shfl_xor(rm, 32));
  float ls = 0.f;
  if (OFF) {
    if (__any(rm > 8.0f)) {
      const float d = (rm > 8.0f) ? rm : 0.f;
      st.m += d;
      const float sc = fexp2(-d);
      st.l *= sc;
#pragma unroll
      for (int r = 0; r < 16; ++r) { st.o[0][r] *= sc; st.o[1][r] *= sc; s0[r] -= d; s1[r] -= d; }
    }
#pragma unroll
    for (int r = 0; r < 16; ++r) { s0[r] = fexp2(s0[r]); s1[r] = fexp2(s1[r]); ls += s0[r] + s1[r]; }
  } else {
    const float mnew = fmaxf(st.m, rm);
    const float mref = (mnew == NEG_INF) ? 0.f : mnew;
    if (__any(mnew > st.m)) {
      const float sc = fexp2(st.m - mref);
      st.l *= sc;
#pragma unroll
      for (int r = 0; r < 16; ++r) { st.o[0][r] *= sc; st.o[1][r] *= sc; }
    }
    st.m = mnew;
#pragma unroll
    for (int r = 0; r < 16; ++r) { s0[r] = fexp2(s0[r] - mref); s1[r] = fexp2(s1[r] - mref); ls += s0[r] + s1[r]; }
  }
  st.l += ls;
  bf16x8 pw[4];
#pragma unroll
  for (int jj = 0; jj < 2; ++jj) {
    u32x4 a, b;
    a.x = pk2(s0[8 * jj], s0[8 * jj + 1]); a.y = pk2(s0[8 * jj + 2], s0[8 * jj + 3]); a.z = pk2(s0[8 * jj + 4], s0[8 * jj + 5]); a.w = pk2(s0[8 * jj + 6], s0[8 * jj + 7]);
    b.x = pk2(s1[8 * jj], s1[8 * jj + 1]); b.y = pk2(s1[8 * jj + 2], s1[8 * jj + 3]); b.z = pk2(s1[8 * jj + 4], s1[8 * jj + 5]); b.w = pk2(s1[8 * jj + 6], s1[8 * jj + 7]);
    pw[jj] = __builtin_bit_cast(bf16x8, a); pw[2 + jj] = __builtin_bit_cast(bf16x8, b);
  }
#pragma unroll
  for (int dh = 0; dh < 2; ++dh) {
    const LAS unsigned char* vrow = Vt + (dh * 32 + r32) * vstride + kvoff + hi * 8;
#pragma unroll
    for (int jj = 0; jj < 4; ++jj) {
      const int kvb = 16 * (jj & 1) + 32 * (jj >> 1);
      const u32x2 lo = *(const LAS u32x2*)(vrow + kvb * 2), hh = *(const LAS u32x2*)(vrow + kvb * 2 + 16);
      u32x4 vv; vv.x = lo.x; vv.y = lo.y; vv.z = hh.x; vv.w = hh.y;
      st.o[dh] = __builtin_amdgcn_mfma_f32_32x32x16_bf16(__builtin_bit_cast(bf16x8, vv), pw[jj], st.o[dh], 0, 0, 0);
    }
  }
}
__device__ __forceinline__ void qk_tile_ini(f32x16& s0, f32x16& s1, const f32x16& ini, const LAS unsigned char* Kt, const bf16x8 (&qr)[4], int r32, int hi) {
  const LAS unsigned char* kb = Kt + r32 * 144 + hi * 16;
#pragma unroll
  for (int d0 = 0; d0 < 4; ++d0) {
    const bf16x8 k0 = *(const LAS bf16x8*)(kb + d0 * 32);
    const bf16x8 k1 = *(const LAS bf16x8*)(kb + 32 * 144 + d0 * 32);
    if (d0 == 0) { s0 = __builtin_amdgcn_mfma_f32_32x32x16_bf16(k0, qr[0], ini, 0, 0, 0); s1 = __builtin_amdgcn_mfma_f32_32x32x16_bf16(k1, qr[0], ini, 0, 0, 0); }
    else { s0 = __builtin_amdgcn_mfma_f32_32x32x16_bf16(k0, qr[d0], s0, 0, 0, 0); s1 = __builtin_amdgcn_mfma_f32_32x32x16_bf16(k1, qr[d0], s1, 0, 0, 0); }
  }
}
__device__ __forceinline__ void qk_tile(f32x16& s0, f32x16& s1, const LAS unsigned char* Kt, const bf16x8 (&qr)[4], int r32, int hi) {
  const LAS unsigned char* kb = Kt + r32 * 144 + hi * 16;
#pragma unroll
  for (int d0 = 0; d0 < 4; ++d0) {
    const bf16x8 k0 = *(const LAS bf16x8*)(kb + d0 * 32);
    const bf16x8 k1 = *(const LAS bf16x8*)(kb + 32 * 144 + d0 * 32);
    s0 = __builtin_amdgcn_mfma_f32_32x32x16_bf16(k0, qr[d0], s0, 0, 0, 0);
    s1 = __builtin_amdgcn_mfma_f32_32x32x16_bf16(k1, qr[d0], s1, 0, 0, 0);
  }
}
template <int MODE>
__device__ __forceinline__ void flash_loop(LAS unsigned char* lds, int jlo, int jhi, const bf16_t* Kg, int kpitch, const bf16_t* Vtg, const float* cgl,
                                           const bf16x8 (&qr)[4], int tq, int jw, unsigned sel_lo, unsigned sel_hi, float cq, SoftState& st, int tid, int r32, int hi) {
  TileRegs R;
  tile_load<MODE>(R, Kg, kpitch, Vtg, cgl, jlo, tid);
  tile_store<MODE>(R, lds, 0, tid);
  if (jlo < jhi) tile_load<MODE>(R, Kg, kpitch, Vtg, cgl, jlo + 1, tid);
  LDS_BARRIER();
  for (int j = jlo; j <= jhi; ++j) {
    const int buf = (j - jlo) & 1;
    if (j < jhi) tile_store<MODE>(R, lds, buf ^ 1, tid);
    if (j + 1 < jhi) tile_load<MODE>(R, Kg, kpitch, Vtg, cgl, j + 2, tid);
    if (j <= jw) {
      f32x16 s0, s1;
      if (MODE == 0) {
        const LAS unsigned char* ck = lds + AL_CK + buf * 256;
        const float cqm = cq - st.m;
#pragma unroll
        for (int g = 0; g < 4; ++g) {
          const f32x4 c0 = *(const LAS f32x4*)(ck + (8 * g + 4 * hi) * 4), c1 = *(const LAS f32x4*)(ck + (32 + 8 * g + 4 * hi) * 4);
#pragma unroll
          for (int e = 0; e < 4; ++e) { s0[4 * g + e] = cqm - c0[e]; s1[4 * g + e] = cqm - c1[e]; }
        }
        qk_tile(s0, s1, lds + AL_K + buf * 9216, qr, r32, hi);
      } else {
        float nm = -st.m;
        if (MODE == 1) { const unsigned bit = (j < 32) ? ((sel_lo >> j) & 1u) : ((sel_hi >> (j - 32)) & 1u); nm = bit ? nm : NEG_INF; }
        f32x16 ini;
#pragma unroll
        for (int r = 0; r < 16; ++r) ini[r] = nm;
        qk_tile_ini(s0, s1, ini, lds + AL_K + buf * 9216, qr, r32, hi);
      }
      const int lim_hi = tq - 64 * j;
      if (lim_hi < 63) {
#pragma unroll
        for (int r = 0; r < 16; ++r) { const int kv = crow(r, hi); if (kv > lim_hi) s0[r] = NEG_INF; if (kv + 32 > lim_hi) s1[r] = NEG_INF; }
      }
      if (MODE == 2) {
        const int lim_lo = tq - 512 - 64 * j;
        if (lim_lo >= 0) {
#pragma unroll
          for (int r = 0; r < 16; ++r) { const int kv = crow(r, hi); if (kv <= lim_lo) s0[r] = NEG_INF; if (kv + 32 <= lim_lo) s1[r] = NEG_INF; }
        }
      }
      softmax_pv<true>(s0, s1, st, lds + AL_V + buf * 9216, 144, 0, r32, hi);
    }
    LDS_BARRIER();
  }
}
__device__ __forceinline__ float merge_l(float l) { return l + __shfl_xor(l, 32); }

__device__ __forceinline__ void fox_unit(int b, int h, int qt, const bf16_t* proj, const bf16_t* vt, const float* c2, const float* kn, bf16_t* ab3, LAS unsigned char* lds, int tid, int wid, int lane) {
  const int r32 = lane & 31, hi = lane >> 5;
  const int q0 = qt * 256 + wid * 32, tq = q0 + r32;
  const size_t tok = (size_t)b * T + tq;
  bf16x8 qr[4];
#pragma unroll
  for (int d0 = 0; d0 < 4; ++d0) qr[d0] = *(const bf16x8*)(proj + tok * NP + C_FQ + h * 64 + d0 * 16 + hi * 8);
  const float* cgl = c2 + (size_t)(b * 4 + h) * T;
  const float cq = cgl[tq];
  SoftState st; st.m = 0.f; st.l = 0.f; st.o[0] = f32x16{}; st.o[1] = f32x16{};
  int jstart = 0;
  {
    float qq = 0.f;
#pragma unroll
    for (int d0 = 0; d0 < 4; ++d0) { const u32x4 w = __builtin_bit_cast(u32x4, qr[d0]);
      const float f[8] = {lo16(w.x), hi16(w.x), lo16(w.y), hi16(w.y), lo16(w.z), hi16(w.z), lo16(w.w), hi16(w.w)};
#pragma unroll
      for (int e = 0; e < 8; ++e) qq += f[e] * f[e]; }
    qq += __shfl_xor(qq, 32);
#pragma unroll
    for (int o = 1; o < 32; o <<= 1) qq = fmaxf(qq, __shfl_xor(qq, o));
    LAS float* red = (LAS float*)(lds + AL_U + 16);
    if (lane == 0) red[wid] = qq;
    __syncthreads();
    float qmax = red[0];
#pragma unroll
    for (int w = 1; w < 8; ++w) qmax = fmaxf(qmax, red[w]);
    qmax = sqrtf(qmax) * 1.001f;
    const int jhi_u = (qt * 256 + 255) >> 6;
    float kk = (lane <= jhi_u) ? kn[(size_t)(b * 4 + h) * 64 + lane] : 0.f;
    float kall = kk;
#pragma unroll
    for (int o = 1; o < 64; o <<= 1) kall = fmaxf(kall, __shfl_xor(kall, o));
    const float c_first = cgl[qt * 256];
    const float c_last = cgl[(lane <= jhi_u) ? (64 * lane + 63) : (T - 1)];
    const bool skip = (lane <= jhi_u) && (2.0f * qmax * kall + 44.0f + (c_first - c_last) < 0.f);
    const unsigned long long bal = __ballot(skip);
    jstart = (~bal == 0ull) ? 64 : (__ffsll((long long)~bal) - 1);
    if (jstart > (qt * 256) >> 6) jstart = (qt * 256) >> 6;
    __syncthreads();
  }
  flash_loop<0>(lds, jstart, (qt * 256 + 255) >> 6, proj + (size_t)b * T * NP + C_FK + h * 64, NP, vt + ((size_t)((2 + h) * GB + b) * 64) * T, cgl, qr, tq, q0 >> 6, 0u, 0u, cq, st, tid, r32, hi);
  const float inv = frcp(merge_l(st.l));
  const bf16_t* gp = proj + tok * NP + C_GATE + 768 + h * 64;
  bf16_t* op = ab3 + tok * 256 + h * 64;
#pragma unroll
  for (int dh = 0; dh < 2; ++dh)
#pragma unroll
    for (int g = 0; g < 4; ++g) {
      const int d = 32 * dh + 8 * g + 4 * hi;
      const u32x2 gw = *(const u32x2*)(gp + d);
      const float v0 = st.o[dh][4 * g] * inv * siluf_(lo16(gw.x)), v1 = st.o[dh][4 * g + 1] * inv * siluf_(hi16(gw.x));
      const float v2 = st.o[dh][4 * g + 2] * inv * siluf_(lo16(gw.y)), v3 = st.o[dh][4 * g + 3] * inv * siluf_(hi16(gw.y));
      u32x2 w; w.x = pk2(v0, v1); w.y = pk2(v2, v3); *(u32x2*)(op + d) = w;
    }
}

__device__ __forceinline__ void nsa_unit(int b, int qt, const bf16_t* proj, const bf16_t* vt, const bf16_t* kc, const bf16_t* vcT, bf16_t* ab0, LAS unsigned char* lds, int tid, int wid, int lane) {
  const int r32 = lane & 31, hi = lane >> 5, head = wid & 3, th = wid >> 2;
  const int q0 = qt * 64, ql = th * 32 + r32, tq = q0 + ql;
  const size_t tok = (size_t)b * T + tq;
#pragma unroll
  for (int i = 0; i < 4; ++i) { const int chn = tid + 512 * i; const int row = chn >> 3, c = chn & 7;
    *(LAS u32x4*)(lds + AL_KC + row * 144 + c * 16) = *(const u32x4*)(kc + ((size_t)b * 256 + row) * 64 + c * 8); }
#pragma unroll
  for (int i = 0; i < 4; ++i) { const int chn = tid + 512 * i; const int row = chn >> 5, c = chn & 31;
    *(LAS u32x4*)(lds + AL_VC + row * 528 + c * 16) = *(const u32x4*)(vcT + ((size_t)b * 64 + row) * 256 + c * 8); }
  LAS float* imp0 = (LAS float*)(lds + AL_IMP); LAS float* imp1 = (LAS float*)(lds + 0); LAS float* imp2 = (LAS float*)(lds + 16640); LAS float* imp3 = (LAS float*)(lds + 128768);
  const bool need_imp = qt >= 16;
  if (need_imp) { for (int e = tid; e < 64 * 65; e += 512) { imp0[e] = 0.f; imp1[e] = 0.f; imp2[e] = 0.f; imp3[e] = 0.f; } }
  LAS float* imp = (head == 0) ? imp0 : (head == 1) ? imp1 : (head == 2) ? imp2 : imp3;
  bf16x8 qr[4];
#pragma unroll
  for (int d0 = 0; d0 < 4; ++d0) qr[d0] = *(const bf16x8*)(proj + tok * NP + C_Q + head * 64 + d0 * 16 + hi * 8);
  __syncthreads();
  const int nmaxq = (tq - 31) >> 4;
  int ncnt = q0 / 16 + 3; if (ncnt > 255) ncnt = 255;
  const int ntc = (ncnt + 63) >> 6;
  float Bq;
  {
    LAS float* red8 = (LAS float*)(lds + AL_U + 128);
    float kq = 0.f;
    if (tid < 256) {
#pragma unroll
      for (int c = 0; c < 8; ++c) { const u32x4 v = *(const LAS u32x4*)(lds + AL_KC + tid * 144 + c * 16);
        const float f[8] = {lo16(v.x), hi16(v.x), lo16(v.y), hi16(v.y), lo16(v.z), hi16(v.z), lo16(v.w), hi16(v.w)};
#pragma unroll
        for (int e = 0; e < 8; ++e) kq += f[e] * f[e]; }
    }
#pragma unroll
    for (int o = 1; o < 64; o <<= 1) kq = fmaxf(kq, __shfl_xor(kq, o));
    if (lane == 0) red8[wid] = kq;
    __syncthreads();
    float kmax2 = red8[0];
#pragma unroll
    for (int w = 1; w < 8; ++w) kmax2 = fmaxf(kmax2, red8[w]);
    float qq = 0.f;
#pragma unroll
    for (int d0 = 0; d0 < 4; ++d0) { const u32x4 w = __builtin_bit_cast(u32x4, qr[d0]);
      const float f[8] = {lo16(w.x), hi16(w.x), lo16(w.y), hi16(w.y), lo16(w.z), hi16(w.z), lo16(w.w), hi16(w.w)};
#pragma unroll
      for (int e = 0; e < 8; ++e) qq += f[e] * f[e]; }
    qq += __shfl_xor(qq, 32);
    Bq = fminf(sqrtf(qq * kmax2) * 1.001f, 60.0f);
  }
  float l = 0.f;
  f32x16 oc[2]; oc[0] = f32x16{}; oc[1] = f32x16{};
  for (int jt = 0; jt < ntc; ++jt) {
    f32x16 s0 = {}, s1 = {};
    qk_tile(s0, s1, lds + AL_KC + jt * 64 * 144, qr, r32, hi);
    const int lim = nmaxq - 64 * jt;
#pragma unroll
    for (int r = 0; r < 16; ++r) { const int kv = crow(r, hi);
      s0[r] = (kv > lim) ? 0.f : fexp2(s0[r] - Bq); s1[r] = (kv + 32 > lim) ? 0.f : fexp2(s1[r] - Bq); l += s0[r] + s1[r]; }
    if (need_imp) {
      {
#pragma unroll
        for (int sub = 0; sub < 2; ++sub)
#pragma unroll
          for (int g = 0; g < 4; ++g) {
            const f32x16& s = sub ? s1 : s0;
            const int jg = 16 * jt + 8 * sub + 2 * g + hi;
            imp[ql * 65 + jg] += (s[4 * g] + s[4 * g + 1]) + (s[4 * g + 2] + s[4 * g + 3]);
          }
        asm volatile("s_waitcnt lgkmcnt(0)" ::: "memory");
#pragma unroll
        for (int sub = 0; sub < 2; ++sub)
#pragma unroll
          for (int g = 0; g < 4; ++g) {
            const f32x16& s = sub ? s1 : s0;
            const int jg = 16 * jt + 8 * sub + 2 * g + hi;
            if (jg + 1 < 64) imp[ql * 65 + jg + 1] += s[4 * g + 3];
          }
      }
      asm volatile("s_waitcnt lgkmcnt(0)" ::: "memory");
    }
    bf16x8 pw[4];
#pragma unroll
    for (int jj = 0; jj < 2; ++jj) {
      u32x4 a, bq;
      a.x = pk2(s0[8 * jj], s0[8 * jj + 1]); a.y = pk2(s0[8 * jj + 2], s0[8 * jj + 3]); a.z = pk2(s0[8 * jj + 4], s0[8 * jj + 5]); a.w = pk2(s0[8 * jj + 6], s0[8 * jj + 7]);
      bq.x = pk2(s1[8 * jj], s1[8 * jj + 1]); bq.y = pk2(s1[8 * jj + 2], s1[8 * jj + 3]); bq.z = pk2(s1[8 * jj + 4], s1[8 * jj + 5]); bq.w = pk2(s1[8 * jj + 6], s1[8 * jj + 7]);
      pw[jj] = __builtin_bit_cast(bf16x8, a); pw[2 + jj] = __builtin_bit_cast(bf16x8, bq);
    }
#pragma unroll
    for (int dh = 0; dh < 2; ++dh) {
      const LAS unsigned char* vrow = lds + AL_VC + (dh * 32 + r32) * 528 + jt * 128 + hi * 8;
#pragma unroll
      for (int jj = 0; jj < 4; ++jj) {
        const int kvb = 16 * (jj & 1) + 32 * (jj >> 1);
        const u32x2 lo = *(const LAS u32x2*)(vrow + kvb * 2), hh = *(const LAS u32x2*)(vrow + kvb * 2 + 16);
        u32x4 vv; vv.x = lo.x; vv.y = lo.y; vv.z = hh.x; vv.w = hh.y;
        oc[dh] = __builtin_amdgcn_mfma_f32_32x32x16_bf16(__builtin_bit_cast(bf16x8, vv), pw[jj], oc[dh], 0, 0, 0);
      }
    }
  }
  l = merge_l(l);
  const float linv = (l > 0.f) ? frcp(l) : 0.f;
#pragma unroll
  for (int r = 0; r < 16; ++r) { oc[0][r] *= linv; oc[1][r] *= linv; }
  LAS float* linvL = (LAS float*)(lds + AL_U + 256);
  if (hi == 0) linvL[head * 64 + ql] = linv;
  __syncthreads();
  LAS unsigned* selw = (LAS unsigned*)(lds + AL_SEL);
  if (qt + 1 <= 16) {
    if (tid < 64) { const unsigned long long mk = (qt + 1 >= 64) ? ~0ull : ((1ull << (qt + 1)) - 1ull); selw[tid * 2] = (unsigned)mk; selw[tid * 2 + 1] = (unsigned)(mk >> 32); }
  } else {
#pragma unroll 1
    for (int i = 0; i < 8; ++i) {
      const int qi = wid * 8 + i;
      const bool valid = lane <= qt, forced = (lane == 0) || (lane == qt) || (lane == qt - 1);
      float val = ((imp0[qi * 65 + lane] * linvL[qi] + imp1[qi * 65 + lane] * linvL[64 + qi]) + imp2[qi * 65 + lane] * linvL[128 + qi]) + imp3[qi * 65 + lane] * linvL[192 + qi];
      val = valid ? (forced ? val + 1.0e4f : val) : -1.0e30f;
      int rank = 0;
#pragma unroll 4
      for (int jj = 0; jj < 64; ++jj) {
        const float o = __builtin_bit_cast(float, __builtin_amdgcn_readlane(__builtin_bit_cast(int, val), jj));
        rank += (o > val || (o == val && jj < lane)) ? 1 : 0;
      }
      const unsigned long long mk = __ballot(rank < 16);
      if (lane == 0) { selw[qi * 2] = (unsigned)mk; selw[qi * 2 + 1] = (unsigned)(mk >> 32); }
    }
  }
  __syncthreads();
  const unsigned sel_lo = selw[ql * 2], sel_hi = selw[ql * 2 + 1];
  const bf16_t* sm = proj + tok * NP + C_SM;
  const float g0 = sigmoidf_(bf2f(sm[head])), g1 = sigmoidf_(bf2f(sm[4 + head])), g2 = sigmoidf_(bf2f(sm[8 + head]));
  LAS float* stash = (LAS float*)(lds + AL_KC) + wid * 2048 + lane;
#pragma unroll
  for (int r = 0; r < 16; ++r) { stash[r * 64] = g0 * oc[0][r]; stash[(16 + r) * 64] = g0 * oc[1][r]; }
  f32x16 ot[2];
  {
    SoftState st; st.m = 0.f; st.l = 0.f; st.o[0] = f32x16{}; st.o[1] = f32x16{};
#ifndef NSA_NO_SEL
    flash_loop<1>(lds, 0, qt, proj + (size_t)b * T * NP + C_KS, NP, vt + ((size_t)(0 * GB + b) * 64) * T, nullptr, qr, tq, qt, sel_lo, sel_hi, 0.f, st, tid, r32, hi);
#endif
    const float sc = g1 * frcp(merge_l(st.l));
#pragma unroll
    for (int r = 0; r < 16; ++r) { stash[r * 64] += sc * st.o[0][r]; stash[(16 + r) * 64] += sc * st.o[1][r]; }
  }
  {
    SoftState st; st.m = 0.f; st.l = 0.f; st.o[0] = f32x16{}; st.o[1] = f32x16{};
#ifndef NSA_NO_WIN
    flash_loop<2>(lds, (qt >= 8) ? qt - 8 : 0, qt, proj + (size_t)b * T * NP + C_KW, NP, vt + ((size_t)(1 * GB + b) * 64) * T, nullptr, qr, tq, qt, 0u, 0u, 0.f, st, tid, r32, hi);
#endif
    const float sc = g2 * frcp(merge_l(st.l));
#pragma unroll
    for (int r = 0; r < 16; ++r) { ot[0][r] = stash[r * 64] + sc * st.o[0][r]; ot[1][r] = stash[(16 + r) * 64] + sc * st.o[1][r]; }
  }
  const bf16_t* gp = proj + tok * NP + C_GATE + head * 64;
  bf16_t* op = ab0 + tok * 256 + head * 64;
#pragma unroll
  for (int dh = 0; dh < 2; ++dh)
#pragma unroll
    for (int g = 0; g < 4; ++g) {
      const int d = 32 * dh + 8 * g + 4 * hi;
      const u32x2 gw = *(const u32x2*)(gp + d);
      const float v0 = ot[dh][4 * g] * siluf_(lo16(gw.x)), v1 = ot[dh][4 * g + 1] * siluf_(hi16(gw.x));
      const float v2 = ot[dh][4 * g + 2] * siluf_(lo16(gw.y)), v3 = ot[dh][4 * g + 3] * siluf_(hi16(gw.y));
      u32x2 w; w.x = pk2(v0, v1); w.y = pk2(v2, v3); *(u32x2*)(op + d) = w;
    }
  __syncthreads();
}
struct D1Regs { u32x4 w[4], a[2]; };
__device__ __forceinline__ void d1_load(D1Regs& R, const bf16_t* ab, const bf16_t* wbT, int pm, int pn, int s, unsigned goff) {
  const int i = s >> 2, kc = s & 3;
  const unsigned char* wbase = (const unsigned char*)(wbT + ((size_t)(i * 1024 + pn * 256)) * 256 + kc * 64);
  const unsigned char* abase = (const unsigned char*)(ab + ((size_t)i * MG + pm * 128) * 256 + kc * 64);
#pragma unroll
  for (int q = 0; q < 4; ++q) R.w[q] = *(const u32x4*)(wbase + q * 32768 + goff);
#pragma unroll
  for (int q = 0; q < 2; ++q) R.a[q] = *(const u32x4*)(abase + q * 32768 + goff);
}
__device__ __forceinline__ void d1_store(const D1Regs& R, LAS unsigned char* st, unsigned loff) {
#pragma unroll
  for (int q = 0; q < 4; ++q) *(LAS u32x4*)(st + q * 9216 + loff) = R.w[q];
#pragma unroll
  for (int q = 0; q < 2; ++q) *(LAS u32x4*)(st + 36864 + q * 9216 + loff) = R.a[q];
}
__device__ __forceinline__ void d1_compute(f32x16 (&acc)[2][2], const LAS unsigned char* st, int wn, int wm, int cperm, int r32, int hi) {
  const LAS unsigned char* wb = st + (wn * 64 + cperm) * 144 + hi * 16;
  const LAS unsigned char* abp = st + 36864 + (wm * 64 + r32) * 144 + hi * 16;
#pragma unroll
  for (int k16 = 0; k16 < 4; ++k16) {
    const bf16x8 w0 = *(const LAS bf16x8*)(wb + k16 * 32), w1 = *(const LAS bf16x8*)(wb + 32 * 144 + k16 * 32);
    const bf16x8 a0 = *(const LAS bf16x8*)(abp + k16 * 32), a1 = *(const LAS bf16x8*)(abp + 32 * 144 + k16 * 32);
    acc[0][0] = __builtin_amdgcn_mfma_f32_32x32x16_bf16(w0, a0, acc[0][0], 0, 0, 0);
    acc[0][1] = __builtin_amdgcn_mfma_f32_32x32x16_bf16(w0, a1, acc[0][1], 0, 0, 0);
    acc[1][0] = __builtin_amdgcn_mfma_f32_32x32x16_bf16(w1, a0, acc[1][0], 0, 0, 0);
    acc[1][1] = __builtin_amdgcn_mfma_f32_32x32x16_bf16(w1, a1, acc[1][1], 0, 0, 0);
  }
}
__device__ __forceinline__ void d1_compute_lite(f32x16 (&dum)[2], const LAS unsigned char* st, int wn, int wm, int cperm, int r32, int hi) {
  const LAS unsigned char* wb = st + (wn * 64 + cperm) * 144 + hi * 16;
  const LAS unsigned char* abp = st + 36864 + (wm * 64 + r32) * 144 + hi * 16;
#pragma unroll
  for (int k16 = 0; k16 < 4; ++k16) {
    const bf16x8 w0 = *(const LAS bf16x8*)(wb + k16 * 32), w1 = *(const LAS bf16x8*)(wb + 32 * 144 + k16 * 32);
    const bf16x8 a0 = *(const LAS bf16x8*)(abp + k16 * 32), a1 = *(const LAS bf16x8*)(abp + 32 * 144 + k16 * 32);
    dum[0] = __builtin_amdgcn_mfma_f32_32x32x16_bf16(w0, a0, dum[0], 0, 0, 0);
    dum[1] = __builtin_amdgcn_mfma_f32_32x32x16_bf16(w0, a1, dum[1], 0, 0, 0);
    dum[0] = __builtin_amdgcn_mfma_f32_32x32x16_bf16(w1, a0, dum[0], 0, 0, 0);
    dum[1] = __builtin_amdgcn_mfma_f32_32x32x16_bf16(w1, a1, dum[1], 0, 0, 0);
  }
}
__device__ __forceinline__ void d1_phase(const bf16_t* ab, const bf16_t* wbT, const unsigned char* gates, bf16_t* tot, LAS unsigned char* lds, int tid, int wid, int lane) {
  const int r32 = lane & 31, hi = lane >> 5, wm = wid & 1, wn = wid >> 1;
  const int cperm = (r32 & ~0xC) | ((r32 & 4) << 1) | ((r32 & 8) >> 1);
  constexpr int STG = 55296;
  const unsigned goff = (unsigned)((tid >> 3) * 512 + (tid & 7) * 16), loff = (unsigned)((tid >> 3) * 144 + (tid & 7) * 16);
  const int nunits = (MG / 128) * 4;
  const int G8 = gridDim.x >> 3, xcd = blockIdx.x & 7, jloc = blockIdx.x >> 3, upx = nunits >> 3;
#pragma unroll 1
  for (int ul = jloc; ul < upx; ul += G8) {
    const int un = xcd * upx + ul;
    const int pn = un & 3, pm = un >> 2;
    const unsigned char* gbase = gates + (size_t)(pm * 128) * NGATE + pn * 256;
    const unsigned ggo = (unsigned)((tid >> 4) * NGATE + (tid & 15) * 16), glo = (unsigned)((tid >> 4) * 264 + (tid & 15) * 16);
    f32x16 acc[2][2]; u32x4 tp[2][2][2];
#pragma unroll
    for (int x = 0; x < 2; ++x)
#pragma unroll
      for (int y = 0; y < 2; ++y) { acc[x][y] = f32x16{}; tp[x][y][0] = u32x4{0u, 0u, 0u, 0u}; tp[x][y][1] = u32x4{0u, 0u, 0u, 0u}; }
    D1Regs R0, R1;
    f32x16 dum[2];
    if (D1_DOUBLE) { dum[0] = f32x16{}; dum[1] = f32x16{}; }
    u32x4 gq[4];
#pragma unroll
    for (int q = 0; q < 4; ++q) gq[q] = *(const u32x4*)(gbase + (size_t)(q * 32) * NGATE + ggo);
    d1_load(R0, ab, wbT, pm, pn, 0, goff);
    d1_load(R1, ab, wbT, pm, pn, 1, goff);
    d1_store(R0, lds, loff);
    LDS_BARRIER();
#pragma unroll 1
    for (int i = 0; i < 4; ++i) {
      const int s0 = 4 * i;
      d1_load(R0, ab, wbT, pm, pn, s0 + 2, goff);
      d1_compute(acc, lds, wn, wm, cperm, r32, hi); if (D1_DOUBLE) d1_compute_lite(dum, lds, wn, wm, cperm, r32, hi);
      d1_store(R1, lds + STG, loff);
      LDS_BARRIER();
      {
        d1_load(R1, ab, wbT, pm, pn, s0 + 3, goff);
        d1_compute(acc, lds + STG, wn, wm, cperm, r32, hi); if (D1_DOUBLE) d1_compute_lite(dum, lds + STG, wn, wm, cperm, r32, hi);
#pragma unroll
        for (int q = 0; q < 4; ++q) *(LAS u32x4*)(lds + 2 * STG + q * 32 * 264 + glo) = gq[q];
        d1_store(R0, lds, loff);
      }
      LDS_BARRIER();
      if (i < 3) d1_load(R0, ab, wbT, pm, pn, s0 + 4, goff);
      d1_compute(acc, lds, wn, wm, cperm, r32, hi); if (D1_DOUBLE) d1_compute_lite(dum, lds, wn, wm, cperm, r32, hi);
      d1_store(R1, lds + STG, loff);
      LDS_BARRIER();
      if (i < 3) {
#pragma unroll
        for (int q = 0; q < 4; ++q) gq[q] = *(const u32x4*)(gbase + (size_t)(q * 32) * NGATE + (i + 1) * 1024 + ggo);
        d1_load(R1, ab, wbT, pm, pn, s0 + 5, goff);
      }
      d1_compute(acc, lds + STG, wn, wm, cperm, r32, hi); if (D1_DOUBLE) d1_compute_lite(dum, lds + STG, wn, wm, cperm, r32, hi);
#pragma unroll
      for (int tm = 0; tm < 2; ++tm)
#pragma unroll
        for (int tn = 0; tn < 2; ++tn)
#pragma unroll
          for (int p = 0; p < 2; ++p) {
            const u32x2 g = *(const LAS u32x2*)(lds + 2 * STG + (wm * 64 + tn * 32 + r32) * 264 + wn * 64 + tm * 32 + 16 * p + 8 * hi);
            const u32x4 t = tp[tm][tn][p]; const f32x16& c = acc[tm][tn];
            u32x4 o;
            o.x = pk2(lo16(t.x) + (float)(g.x & 0xffu) * c[8 * p + 0], hi16(t.x) + (float)((g.x >> 8) & 0xffu) * c[8 * p + 1]);
            o.y = pk2(lo16(t.y) + (float)((g.x >> 16) & 0xffu) * c[8 * p + 2], hi16(t.y) + (float)(g.x >> 24) * c[8 * p + 3]);
            o.z = pk2(lo16(t.z) + (float)(g.y & 0xffu) * c[8 * p + 4], hi16(t.z) + (float)((g.y >> 8) & 0xffu) * c[8 * p + 5]);
            o.w = pk2(lo16(t.w) + (float)((g.y >> 16) & 0xffu) * c[8 * p + 6], hi16(t.w) + (float)(g.y >> 24) * c[8 * p + 7]);
            tp[tm][tn][p] = o;
          }
#pragma unroll
      for (int x = 0; x < 2; ++x)
#pragma unroll
        for (int y = 0; y < 2; ++y) acc[x][y] = f32x16{};
      if (i < 3) d1_store(R0, lds, loff);
      LDS_BARRIER();
    }
    if (D1_DOUBLE) { asm volatile("" :: "v"(dum[0]), "v"(dum[1])); }
    bf16_t* trow = tot + (size_t)(pm * 128 + wm * 64 + r32) * 1024 + pn * 256 + wn * 64 + 8 * hi;
#pragma unroll
    for (int tm = 0; tm < 2; ++tm)
#pragma unroll
      for (int tn = 0; tn < 2; ++tn)
#pragma unroll
        for (int p = 0; p < 2; ++p) {
          *(u32x4*)(trow + (size_t)tn * 32 * 1024 + tm * 32 + 16 * p) = tp[tm][tn][p];
        }
  }
}
#define XB_TMO      128
#define XB_XCNT(j)  (256  + 64 * (j))
#define XB_XSUB(j)  (1280 + 64 * (j))
#define XB_XGEN(j)  (2304 + 64 * (j))
#define XB_TOP      3328
#define XB_TOPGEN   3392
#define XCD_BAR_WORDS 3456
#define XB_SPIN_CAP (1u << 18)

__device__ __forceinline__ unsigned xb_ld(unsigned* p)              { return __hip_atomic_load(p, __ATOMIC_RELAXED, __HIP_MEMORY_SCOPE_AGENT); }
__device__ __forceinline__ unsigned xb_add(unsigned* p, unsigned v) { return __hip_atomic_fetch_add(p, v, __ATOMIC_RELAXED, __HIP_MEMORY_SCOPE_AGENT); }
__device__ __forceinline__ unsigned xb_xcc_id() { return (unsigned)__builtin_amdgcn_s_getreg((3 << 11) | 20) & 0xFu; }
#define XB_SPIN(cond, bar) do { unsigned _sp = 0; while (cond) { __builtin_amdgcn_s_sleep(1); \
    if ((++_sp & 255u) == 0u) { if (xb_ld(&(bar)[XB_TMO])) break; if (_sp > XB_SPIN_CAP) { atomicAdd(&(bar)[XB_TMO], 1u); break; } } } } while (0)

struct XcdBarrier {
    unsigned* bar; unsigned x;
    volatile LAS unsigned* st;
};

__device__ __forceinline__ XcdBarrier xcd_barrier_post(unsigned* bar, volatile LAS unsigned* st) {
    XcdBarrier b; b.bar = bar; b.x = xb_xcc_id(); b.st = st;
    if (threadIdx.x == 0) (void)xb_add(&bar[XB_XCNT(b.x)], 1u);
    return b;
}
__device__ __forceinline__ void xcd_barrier_complete(unsigned* bar, unsigned x, unsigned& nloc, unsigned& nx) {
    const unsigned G = gridDim.x * gridDim.y * gridDim.z;
    unsigned sum, cnt, mine, sp = 0u;
    for (;;) {
        sum = 0u; cnt = 0u; mine = 0u;
#pragma unroll
        for (unsigned j = 0; j < 16; ++j) { const unsigned c = xb_ld(&bar[XB_XCNT(j)]); sum += c; cnt += (c > 0u) ? 1u : 0u; mine = (j == x) ? c : mine; }
        if (sum == G) break;
        __builtin_amdgcn_s_sleep(1);
        if ((++sp & 255u) == 0u) { if (xb_ld(&bar[XB_TMO])) break; if (sp > XB_SPIN_CAP) { atomicAdd(&bar[XB_TMO], 1u); break; } }
    }
    nloc = mine > 0u ? mine : 1u; nx = cnt > 0u ? cnt : 1u;
}

__device__ __forceinline__ void xcd_barrier(const XcdBarrier& b) {
    asm volatile("s_waitcnt vmcnt(0)" ::: "memory");
    __syncthreads();
    if (threadIdx.x == 0) {
        unsigned* bar = b.bar;
        __builtin_amdgcn_s_waitcnt(0);
        unsigned nloc = b.st[0], nx = b.st[1];
        if (nloc == 0u) { xcd_barrier_complete(bar, b.x, nloc, nx); b.st[0] = nloc; b.st[1] = nx; }
        const unsigned old = xb_add(&bar[XB_XSUB(b.x)], 1u);
        const unsigned gen = old / nloc;
        if (old + 1u == (gen + 1u) * nloc) {
            __builtin_amdgcn_fence(__ATOMIC_RELEASE, "agent");
            asm volatile("s_waitcnt vmcnt(0)" ::: "memory");
            const unsigned og = xb_add(&bar[XB_TOP], 1u);
            const unsigned tg = og / nx;
            if (og + 1u == (tg + 1u) * nx) xb_add(&bar[XB_TOPGEN], 1u);
            else XB_SPIN(xb_ld(&bar[XB_TOPGEN]) == tg, bar);
            __builtin_amdgcn_fence(__ATOMIC_ACQUIRE, "agent");
            xb_add(&bar[XB_XGEN(b.x)], 1u);
            asm volatile("s_waitcnt vmcnt(0)" ::: "memory");
        } else {
            XB_SPIN(xb_ld(&bar[XB_XGEN(b.x)]) == gen, bar);
            __builtin_amdgcn_fence(__ATOMIC_ACQUIRE, "agent");
            asm volatile("s_waitcnt vmcnt(0)" ::: "memory");
        }
    }
    __syncthreads();
}

constexpr int CW_BAR = 1024;
constexpr int LDS_BARST = LDS_BYTES - 64;
#define LAYER_BODY(g, l) do { \
      { PHASE_BEGIN(); \
        const float* xin = (l == 0) ? a.x + (size_t)g * MG * DM : a.out + (size_t)g * MG * DM; \
        for (int rep = 0; rep < 1 + REP_MISC + REP_N; ++rep) phase_rows(xin, xb, rstd, MG, gw, ngw, lane); \
        if (l == 0 && g > 0) phase_final_norm(a.out + (size_t)(g - 1) * MG * DM, a.final_g, MG, gw, ngw, lane); \
      } \
      xcd_barrier(xbar); if (REP_SYNC) xcd_barrier(xbar); \
      { PHASE_BEGIN(); \
        pg8::Gemm gm{xb, (const bf16_t*)(ws + WS_WIN) + (size_t)l * NTOT * DM, MG, NTOT, DM}; \
        pg8::StaticOrder S; S.init(MG, NTOT, G, (int)blockIdx.x); \
        EpiA E{proj, gates}; \
        for (int rep = 0; rep < 1 + REP_A; ++rep) { pg8::gemm_phase<EpiA, pg8::StaticOrder, true, true>(lds, gm, S, E); __syncthreads(); } \
        if (REP_A1) { pg8::Gemm gm1{xb, (const bf16_t*)(ws + WS_WIN) + (size_t)l * NTOT * DM, MG, NP, DM}; pg8::StaticOrder S1; S1.init(MG, NP, G, (int)blockIdx.x); pg8::gemm_phase<EpiA, pg8::StaticOrder, true, true>(lds, gm1, S1, E); __syncthreads(); } \
      } \
      xcd_barrier(xbar); if (REP_SYNC) xcd_barrier(xbar); \
      { PHASE_BEGIN(); \
        b1_rope(proj, tab, gt, ngt); \
      } { PHASE_BEGIN(); \
        for (int rep = 0; rep < 1 + REP_B23 + REP_BALL; ++rep) { b2_vtrans(proj, vt, lds, gw, ngw, wid, lane); \
        b3_foxcum(proj, a.fox_f_bias + l * 4, c2, lds, tid, wid, lane); b7_knorm(proj, rstd, gw, ngw, lane); } \
        __syncthreads(); \
      } { PHASE_BEGIN(); \
        for (int rep = 0; rep < 1 + REP_MISC + REP_B4 + REP_BALL; ++rep) b4_compress(proj, (const bf16_t*)(ws + WS_W1T) + (size_t)l * 2 * 128 * 2048, (const bf16_t*)(ws + WS_W2T) + (size_t)l * 2 * 64 * 128, \
                    (const float*)(ws + WS_B1P) + l * 256, a.cmp_b2 + l * 128, tab, kc, vcT, lds, tid, wid, lane); \
        __syncthreads(); \
      } { PHASE_BEGIN(); \
        for (int rep = 0; rep < 1 + REP_B5 + REP_BALL; ++rep) b5_pool_mfma(proj, (const bf16_t*)(ws + WS_PWT) + (size_t)l * 4 * 4096, a.pool_scale + l * 256, ab + (size_t)1 * MG * 256, wid, lane); \
      } { PHASE_BEGIN(); \
        for (int rep = 0; rep < 1 + REP_MISC + REP_BALL; ++rep) b6_conv(proj, a.conv_w + l * 768, ab + (size_t)2 * MG * 256, gt, ngt); \
      } \
      xcd_barrier(xbar); if (REP_SYNC) xcd_barrier(xbar); \
      { PHASE_BEGIN(); \
        for (int rep = 0; rep < 1 + REP_C; ++rep) { \
        unsigned* ctr = (unsigned*)(ws + WS_CTL) + (g * DEPTH + l) + 8 * rep; \
        LAS unsigned* uw = (LAS unsigned*)(lds + AL_U); \
        constexpr int NUNITS = 16 * 8 * GB; \
        for (;;) { \
          if (tid == 0) uw[0] = atomicAdd(ctr, 1u); \
          __syncthreads(); \
          const unsigned u = uw[0]; \
          __syncthreads(); \
          if (u >= (unsigned)NUNITS) break; \
          if (u < (unsigned)(64 * GB)) nsa_unit((int)u % GB, 63 - (int)u / GB, proj, vt, kc, vcT, ab, lds, tid, wid, lane); \
          else { const int v = (int)u - 64 * GB, r = v % (4 * GB); fox_unit(r >> 2, r & 3, 15 - v / (4 * GB), proj, vt, c2, rstd, ab + (size_t)3 * MG * 256, lds, tid, wid, lane); } \
        } \
        __syncthreads(); } \
      } \
      xcd_barrier(xbar); if (REP_SYNC) xcd_barrier(xbar); \
      { PHASE_BEGIN(); \
        for (int rep = 0; rep < 1 + REP_D1; ++rep) d1_phase(ab, (const bf16_t*)(ws + WS_WBT) + (size_t)l * 4 * 1024 * 256, gates, tot, lds, tid, wid, lane); \
      } \
      xcd_barrier(xbar); if (REP_SYNC) xcd_barrier(xbar); \
      { PHASE_BEGIN(); \
        const float* xin = (l == 0) ? a.x + (size_t)g * MG * DM : a.out + (size_t)g * MG * DM; \
        pg8::Gemm gm{tot, (const bf16_t*)(ws + WS_WOT) + (size_t)l * 1024 * 1024, MG, DM, DM}; \
        pg8::StaticOrder S; S.init(MG, DM, G, (int)blockIdx.x); \
        EpiD2 E{xin, a.out + (size_t)g * MG * DM}; \
        for (int rep = 0; rep < 1 + ((l == 0) ? 2 * REP_D2 : 0); ++rep) { pg8::gemm_phase<EpiD2, pg8::StaticOrder, true, true>(lds, gm, S, E); __syncthreads(); } \
      } \
      xcd_barrier(xbar); if (REP_SYNC) xcd_barrier(xbar); \
 \
  } while (0)
__global__ void __launch_bounds__(512, 2) hybrid_fwd(Args a) {
  extern __shared__ __attribute__((aligned(16))) unsigned char lds_raw[];
  LAS unsigned char* lds = (LAS unsigned char*)lds_raw;
  cg::grid_group grid = cg::this_grid();
  const int tid0 = threadIdx.x;
  const int G = gridDim.x;
  const int ngt = G * 512, ngw = G * 8;
#define PHASE_BEGIN() int tid = tid0; asm volatile("" : "+v"(tid)); const int lane = tid & 63, wid = __builtin_amdgcn_readfirstlane(tid >> 6); \
      const int gt = blockIdx.x * 512 + tid, gw = blockIdx.x * 8 + wid; (void)lane; (void)wid; (void)gt; (void)gw; \
      __attribute__((address_space(1))) unsigned char* wsl_ = (__attribute__((address_space(1))) unsigned char*)a.ws; asm volatile("" : "+s"(wsl_)); unsigned char* ws = (unsigned char*)wsl_; \
      float* rstd = (float*)(ws + WS_RSTD); float* c2 = (float*)(ws + WS_CFOX); const float* tab = (const float*)(ws + WS_TAB); \
      bf16_t* kc = (bf16_t*)(ws + WS_KC); bf16_t* vcT = (bf16_t*)(ws + WS_VCT); bf16_t* vt = (bf16_t*)(ws + WS_VT); \
      bf16_t* xb = (bf16_t*)(ws + WS_XB); bf16_t* ab = (bf16_t*)(ws + WS_AB); bf16_t* tot = (bf16_t*)(ws + WS_TOT); \
      bf16_t* proj = (bf16_t*)(ws + WS_PROJ); unsigned char* gates = (unsigned char*)(ws + WS_GATES); \
      (void)rstd; (void)c2; (void)tab; (void)kc; (void)vcT; (void)vt; (void)xb; (void)ab; (void)tot; (void)proj; (void)gates;

  if (tid0 < 16) ((LAS unsigned*)(lds + LDS_BARST))[tid0] = 0u;
  __syncthreads();
  XcdBarrier xbar = xcd_barrier_post((unsigned*)(a.ws + WS_CTL) + CW_BAR, (volatile LAS unsigned*)(lds + LDS_BARST));
  for (int rep = 0; rep < 1 + REP_P0; ++rep) { const int gt = blockIdx.x * 512 + tid0; p0_prologue(a, gt, ngt); }
  grid.sync();

  LAYER_BODY(0, 0); LAYER_BODY(0, 1);
#if NGROUP > 1
  LAYER_BODY(1, 0); LAYER_BODY(1, 1);
#endif
#if NGROUP > 2
  LAYER_BODY(2, 0); LAYER_BODY(2, 1); LAYER_BODY(3, 0); LAYER_BODY(3, 1);
#endif
  { const int lane = tid0 & 63, gw = blockIdx.x * 8 + (tid0 >> 6); phase_final_norm(a.out + (size_t)(NG - 1) * MG * DM, a.final_g, MG, gw, ngw, lane); }
}

extern "C" void kernel_launch(void* const* d_in, const int* in_sizes, int n_in, void* d_out, int out_size, void* d_ws, size_t ws_size, hipStream_t stream) {
  static int grid = 0;
  if (!grid) {
    int dev = 0, cus = 0, per = 0;
    (void)hipGetDevice(&dev); (void)hipDeviceGetAttribute(&cus, hipDeviceAttributeMultiprocessorCount, dev);
    (void)hipFuncSetAttribute((const void*)hybrid_fwd, hipFuncAttributeMaxDynamicSharedMemorySize, LDS_BYTES);
    (void)hipOccupancyMaxActiveBlocksPerMultiprocessor(&per, (const void*)hybrid_fwd, 512, LDS_BYTES);
    if (per < 1) per = 1;
    grid = cus * per;
    if (ws_size < WS_END) fprintf(stderr, "workspace too small: %zu < %zu\n", ws_size, (size_t)WS_END);
  }
  (void)hipMemsetAsync((char*)d_ws + WS_CTL, 0, 18 * 1024, stream);
  Args a{};
  a.x = (const float*)d_in[0]; a.norm_g = (const float*)d_in[1]; a.w_in = (const float*)d_in[2]; a.fox_f_bias = (const float*)d_in[3];
  a.cmp_pos = (const float*)d_in[4]; a.cmp_w1 = (const float*)d_in[5]; a.cmp_b1 = (const float*)d_in[6]; a.cmp_w2 = (const float*)d_in[7];
  a.cmp_b2 = (const float*)d_in[8]; a.pool_w = (const float*)d_in[9]; a.pool_scale = (const float*)d_in[10]; a.conv_w = (const float*)d_in[11];
  a.w_branch = (const float*)d_in[12]; a.w_out = (const float*)d_in[13]; a.final_g = (const float*)d_in[14];
  a.out = (float*)d_out; a.ws = (unsigned char*)d_ws;
  void* args[] = {&a};
  hipError_t e = hipLaunchCooperativeKernel((const void*)hybrid_fwd, dim3(grid), dim3(512), args, LDS_BYTES, stream);
  if (e != hipSuccess) fprintf(stderr, "cooperative launch failed: %s (grid %d)\n", hipGetErrorString(e), grid);
}
```

```cpp
#include <hip/hip_runtime.h>
#include <hip/hip_cooperative_groups.h>
#include <cstdio>
#include <cstdint>
namespace cg = cooperative_groups;
namespace pg8 {
#define PG8_LAS __attribute__((address_space(3)))
typedef unsigned short bf16_t;
typedef short bf16x8 __attribute__((ext_vector_type(8)));
typedef float f32x4 __attribute__((ext_vector_type(4)));
typedef unsigned u32x4 __attribute__((ext_vector_type(4)));
constexpr int BM = 256, BK = 64, HALF = 128, HTB = HALF * BK * 2  , STAGE_BYTES = 8 * HTB, NXCD = 8, WGM = 8;

__host__ __device__ __forceinline__ int lds_byte(int r, int c) { const int st = (r >> 4) * 2 + (c >> 5), rr = r & 15, cc = c & 31, ob = rr * 64 + cc * 2; return st * 1024 + (ob ^ (((ob >> 9) & 1) << 5)); }
__host__ __device__ __forceinline__ void stage_rc(int b, int& R, int& C) { const int st = b / 1024, sb = b % 1024, swz = sb ^ (((sb >> 9) & 1) << 5); R = (st >> 1) * 16 + swz / 64; C = (st & 1) * 32 + (swz % 64) / 2; }
__host__ __device__ __forceinline__ int perm32(int rho) { const int n = rho >> 4, i = rho & 15; return 8 * (i >> 2) + 4 * n + (i & 3); }

struct Unit { int pm, pn; };
struct Gemm { const bf16_t* A; const bf16_t* Bt; int M, N, K; };

struct StaticOrder {
    int nM, nN, nwg, G, c;
    __host__ __device__ void init(int M, int N, int G_, int c_) { nM = M / BM; nN = N / BM; nwg = nM * nN; G = G_; c = c_; }
    __host__ __device__ bool next(int i, Unit& u) const {
        const long L = (long)i * G + c; if (L >= nwg) return false;
        int wgid = (int)L; { const int q = nwg / NXCD, r = nwg % NXCD, xcd = wgid % NXCD, off = wgid / NXCD; wgid = (xcd < r ? xcd * (q + 1) : r * (q + 1) + (xcd - r) * q) + off; }
        const int nig = WGM * nN, gid = wgid / nig, fm = gid * WGM, gsz = (nM - fm) < WGM ? (nM - fm) : WGM;
        u.pm = fm + ((wgid % nig) % gsz); u.pn = (wgid % nig) / gsz; return true;
    }
    __device__ __forceinline__ void a_ready(const Unit&) const {}
    __device__ __forceinline__ void done(const Unit&) const {}
};

__device__ __forceinline__ unsigned cvt_pk_bf16(float lo, float hi) { unsigned r; asm volatile("v_cvt_pk_bf16_f32 %0, %1, %2" : "=v"(r) : "v"(lo), "v"(hi)); return r; }
template <class Epi, class Sched, bool ALIGN_EPI = false, bool SP2 = false>
__device__ __forceinline__ void gemm_phase(PG8_LAS unsigned char* lds, const Gemm g, const Sched& S, const Epi& E) {
    int tid = threadIdx.x; asm volatile("" : "+v"(tid)); const int wid = __builtin_amdgcn_readfirstlane(tid >> 6), lane = tid & 63, wr = wid >> 2, wc = wid & 3, fr = lane & 15, fq = lane >> 4;
    const int K = g.K, nt = K / BK;
    unsigned voffA[2], voffB[2];
#pragma unroll
    for (int i = 0; i < 2; ++i) { int R, C; stage_rc(tid * 16 + i * 8192, R, C); const int Rb = Epi::PERM ? ((R & ~31) + perm32(R & 31)) : R;
        voffA[i] = (unsigned)(R * K + C) * 2u; voffB[i] = (unsigned)(Rb * K + C) * 2u; }
    const size_t kstep = (size_t)(BK * 2);
    const size_t hstep = (size_t)HALF * K * 2;
    const size_t tstep = 2 * hstep;
    const unsigned ldsw = (unsigned)wid * 1024u;
    const int aoff = lds_byte(wr * 64 + fr, fq * 8), boff = lds_byte(wc * 32 + fr, fq * 8);
#define PG8_SA(b, h) (((b) * 2 + (h)) * HTB)
#define PG8_SB(b, h) ((4 + (b) * 2 + (h)) * HTB)
#define PG8_STAGE(bufoff, gbase, voff) do { _Pragma("unroll") for (int _i = 0; _i < 2; ++_i) \
        __builtin_amdgcn_global_load_lds((const unsigned*)((const char*)(gbase) + (voff)[_i]), (PG8_LAS unsigned*)(lds + (bufoff) + ldsw + _i * 8192), 16, 0, 0); } while (0)
#define PG8_LDA(dst, b, h) do { _Pragma("unroll") for (int m = 0; m < 4; ++m) _Pragma("unroll") for (int k = 0; k < 2; ++k) dst[m][k] = *(const PG8_LAS bf16x8*)(lds + PG8_SA(b, h) + aoff + m * 2048 + k * 1024); } while (0)
#define PG8_LDB(dst, b, h) do { _Pragma("unroll") for (int n = 0; n < 2; ++n) _Pragma("unroll") for (int k = 0; k < 2; ++k) dst[n][k] = *(const PG8_LAS bf16x8*)(lds + PG8_SB(b, h) + boff + n * 2048 + k * 1024); } while (0)
#define PG8_MMA(ai, bj, At, Bt) do { __builtin_amdgcn_s_setprio(1); _Pragma("unroll") for (int m = 0; m < 4; ++m) _Pragma("unroll") for (int n = 0; n < 2; ++n) _Pragma("unroll") for (int k = 0; k < 2; ++k) \
        acc[ai][bj][m][n] = __builtin_amdgcn_mfma_f32_16x16x32_bf16(Bt[n][k], At[m][k], acc[ai][bj][m][n], 0, 0, 0); __builtin_amdgcn_s_setprio(0); } while (0)
#define PG8_WAIT_V(n) asm volatile("s_waitcnt vmcnt(" #n ")" ::: "memory")
#define PG8_WAIT_L(n) asm volatile("s_waitcnt lgkmcnt(" #n ")" ::: "memory")
#define PG8_BAR __builtin_amdgcn_s_barrier()
#define PG8_SCHED __builtin_amdgcn_sched_barrier(0)
    Unit cur, nxt; int ui = 0;
    if (!S.next(0, cur)) return;
    f32x4 acc[2][2][4][2];
#pragma unroll
    for (int a = 0; a < 2; ++a)
#pragma unroll
        for (int b = 0; b < 2; ++b)
#pragma unroll
            for (int m = 0; m < 4; ++m)
#pragma unroll
                for (int n = 0; n < 2; ++n) acc[a][b][m][n] = (f32x4){0.f, 0.f, 0.f, 0.f};
    bf16x8 At[4][2], B0[2][2], B1[2][2];
    const char* cA = (const char*)g.A + (size_t)cur.pm * tstep; const char* cB = (const char*)g.Bt + (size_t)cur.pn * tstep;
    S.a_ready(cur);
    if constexpr (SP2) {
        PG8_STAGE(PG8_SB(0, 0), cB, voffB); PG8_STAGE(PG8_SB(0, 1), cB + hstep, voffB); PG8_STAGE(PG8_SA(0, 0), cA, voffA); PG8_STAGE(PG8_SA(0, 1), cA + hstep, voffA);
        if (wr == 1) PG8_BAR;
        PG8_WAIT_V(2); PG8_BAR;
        PG8_STAGE(PG8_SB(1, 0), cB + kstep, voffB); PG8_STAGE(PG8_SA(1, 0), cA + kstep, voffA); PG8_STAGE(PG8_SB(1, 1), cB + hstep + kstep, voffB);
        PG8_WAIT_V(6); PG8_BAR;
    } else {
        PG8_STAGE(PG8_SB(0, 0), cB, voffB); PG8_STAGE(PG8_SA(0, 0), cA, voffA); PG8_STAGE(PG8_SB(0, 1), cB + hstep, voffB); PG8_STAGE(PG8_SA(0, 1), cA + hstep, voffA);
        if (wr == 1) PG8_BAR;
        PG8_WAIT_V(4); PG8_BAR;
        PG8_STAGE(PG8_SB(1, 0), cB + kstep, voffB); PG8_STAGE(PG8_SA(1, 0), cA + kstep, voffA); PG8_STAGE(PG8_SB(1, 1), cB + hstep + kstep, voffB);
        PG8_WAIT_V(6); PG8_BAR;
    }
    for (;;) {
        const bool has_next = S.next(ui + 1, nxt);
        const char* nA = has_next ? (const char*)g.A + (size_t)nxt.pm * tstep : cA; const char* nB = has_next ? (const char*)g.Bt + (size_t)nxt.pn * tstep : cB;
        for (int t = 0; t < nt; t += 2) {
            const bool last = (t == nt - 2);
            const char* a1 = cA + (size_t)(t + 1) * kstep;
            const char* a2 = last ? nA : cA + (size_t)(t + 2) * kstep; const char* b2 = last ? nB : cB + (size_t)(t + 2) * kstep;
            const char* a3 = a2 + kstep; const char* b3 = b2 + kstep;
            if (last && has_next) S.a_ready(nxt);
            if constexpr (SP2) {
            PG8_LDB(B0, 0, 0); PG8_LDB(B1, 0, 1); PG8_SCHED; PG8_LDA(At, 0, 0); PG8_STAGE(PG8_SA(1, 1), a1 + hstep, voffA);
            PG8_WAIT_V(8); PG8_WAIT_L(0); PG8_BAR; PG8_MMA(0, 0, At, B0); PG8_MMA(0, 1, At, B1); PG8_BAR; PG8_SCHED;
            PG8_LDA(At, 0, 1); PG8_STAGE(PG8_SB(0, 0), b2, voffB); PG8_STAGE(PG8_SB(0, 1), b2 + hstep, voffB); PG8_STAGE(PG8_SA(0, 0), a2, voffA);
            PG8_WAIT_V(8); PG8_WAIT_L(0); PG8_BAR; PG8_MMA(1, 0, At, B0); PG8_MMA(1, 1, At, B1); PG8_BAR; PG8_SCHED;
            PG8_LDB(B0, 1, 0); PG8_LDB(B1, 1, 1); PG8_SCHED; PG8_LDA(At, 1, 0); PG8_STAGE(PG8_SA(0, 1), a2 + hstep, voffA);
            PG8_WAIT_V(8); PG8_WAIT_L(0); PG8_BAR; PG8_MMA(0, 0, At, B0); PG8_MMA(0, 1, At, B1); PG8_BAR; PG8_SCHED;
            PG8_LDA(At, 1, 1); PG8_STAGE(PG8_SB(1, 0), b3, voffB); PG8_STAGE(PG8_SB(1, 1), b3 + hstep, voffB); PG8_STAGE(PG8_SA(1, 0), a3, voffA);
            PG8_WAIT_V(8); PG8_WAIT_L(0); PG8_BAR; PG8_MMA(1, 0, At, B0); PG8_MMA(1, 1, At, B1); PG8_BAR; PG8_SCHED;
            } else {
            PG8_LDB(B0, 0, 0); PG8_SCHED; PG8_LDA(At, 0, 0); PG8_STAGE(PG8_SA(1, 1), a1 + hstep, voffA);
            PG8_WAIT_L(8); PG8_BAR; PG8_WAIT_L(0); PG8_MMA(0, 0, At, B0); PG8_BAR; PG8_SCHED;
            PG8_LDB(B1, 0, 1); PG8_STAGE(PG8_SB(0, 0), b2, voffB);
            PG8_BAR; PG8_WAIT_L(0); PG8_MMA(0, 1, At, B1); PG8_BAR;
            PG8_LDA(At, 0, 1); PG8_STAGE(PG8_SA(0, 0), a2, voffA);
            PG8_BAR; PG8_WAIT_L(0); PG8_MMA(1, 0, At, B0); PG8_BAR; PG8_SCHED;
            PG8_STAGE(PG8_SB(0, 1), b2 + hstep, voffB);
            PG8_WAIT_V(6); PG8_BAR; PG8_MMA(1, 1, At, B1); PG8_BAR;
            PG8_LDB(B0, 1, 0); PG8_SCHED; PG8_LDA(At, 1, 0); PG8_STAGE(PG8_SA(0, 1), a2 + hstep, voffA);
            PG8_WAIT_L(8); PG8_BAR; PG8_WAIT_L(0); PG8_MMA(0, 0, At, B0); PG8_BAR; PG8_SCHED;
            PG8_LDB(B1, 1, 1); PG8_STAGE(PG8_SB(1, 0), b3, voffB);
            PG8_BAR; PG8_WAIT_L(0); PG8_MMA(0, 1, At, B1); PG8_BAR;
            PG8_LDA(At, 1, 1); PG8_STAGE(PG8_SA(1, 0), a3, voffA);
            PG8_BAR; PG8_WAIT_L(0); PG8_MMA(1, 0, At, B0); PG8_BAR; PG8_SCHED;
            PG8_STAGE(PG8_SB(1, 1), b3 + hstep, voffB);
            PG8_WAIT_V(6); PG8_BAR; PG8_MMA(1, 1, At, B1); PG8_BAR;
            }
        }
        if constexpr (ALIGN_EPI) { if (wr == 0) PG8_BAR; }
        if constexpr (!Epi::AFTER_DRAIN) { E(acc, cur, wr, wc, fr, fq); S.done(cur); }
        if (!has_next) break;
#pragma unroll
        for (int a = 0; a < 2; ++a)
#pragma unroll
            for (int b = 0; b < 2; ++b)
#pragma unroll
                for (int m = 0; m < 4; ++m)
#pragma unroll
                    for (int n = 0; n < 2; ++n) acc[a][b][m][n] = (f32x4){0.f, 0.f, 0.f, 0.f};
        cur = nxt; cA = nA; cB = nB; ++ui;
        if constexpr (ALIGN_EPI) { if (wr == 1) PG8_BAR; }
    }
    PG8_WAIT_V(0);
    if constexpr (!ALIGN_EPI) { if (wr == 0) PG8_BAR; }
    PG8_BAR;
    if constexpr (Epi::AFTER_DRAIN) { E.fused(acc, cur, wr, wc, fr, fq, lds, wid, lane); S.done(cur); }
#undef PG8_SA
#undef PG8_SB
#undef PG8_STAGE
#undef PG8_LDA
#undef PG8_LDB
#undef PG8_MMA
#undef PG8_WAIT_V
#undef PG8_WAIT_L
#undef PG8_BAR
#undef PG8_SCHED
}
}
#define LAS __attribute__((address_space(3)))
typedef unsigned short bf16_t;
typedef short bf16x8 __attribute__((ext_vector_type(8)));
typedef float f32x4 __attribute__((ext_vector_type(4)));
typedef float f32x16 __attribute__((ext_vector_type(16)));
typedef unsigned u32x4 __attribute__((ext_vector_type(4)));
typedef unsigned u32x2 __attribute__((ext_vector_type(2)));
typedef float f32x2_t __attribute__((ext_vector_type(2)));
typedef __bf16 bf16x2_t __attribute__((ext_vector_type(2)));

constexpr int T = 4096, DM = 1024, NBATCH = 16, DEPTH = 2;
#ifndef REP_P0
#define REP_P0 0
#endif
#ifndef REP_SYNC
#define REP_SYNC 0
#endif
#ifndef REP_MISC
#define REP_MISC 0
#endif
#ifndef REP_D2
#define REP_D2 0
#endif
#ifndef REP_B4
#define REP_B4 0
#endif
#ifndef REP_BALL
#define REP_BALL 0
#endif
#ifndef REP_N
#define REP_N 0
#endif
#ifndef REP_A1
#define REP_A1 0
#endif
#ifndef D1_DOUBLE
#define D1_DOUBLE 0
#endif
#ifndef REP_A
#define REP_A 0
#endif
#ifndef REP_C
#define REP_C 0
#endif
#ifndef REP_D1
#define REP_D1 0
#endif
#ifndef REP_B5
#define REP_B5 0
#endif
#ifndef REP_B23
#define REP_B23 0
#endif
#ifndef NGROUP
#define NGROUP 1
#endif
constexpr int NG = NGROUP, GB = NBATCH / NG, MG = GB * T;
constexpr int NP = 3584, NGATE = 4096, NTOT = NP + NGATE;
constexpr int DIN = 7568;
constexpr int C_Q = 0, C_KC = 256, C_VC = 320, C_KS = 384, C_VS = 448, C_KW = 512, C_VW = 576, C_POOL = 640, C_CX = 896, C_CB = 1152, C_CC = 1408,
              C_FQ = 1664, C_FK = 1920, C_FV = 2176, C_GATE = 2432, C_SM = 3456;
constexpr float LOG2E = 1.4426950408889634f;
constexpr float QS = 0.125f * LOG2E;
constexpr float NEG_INF = -INFINITY;

constexpr size_t MiB = 1u << 20;
constexpr size_t WS_CTL = 0;
constexpr size_t WS_TAB = 64 * 1024;
constexpr size_t WS_B1P = WS_TAB + 256 * 1024;
constexpr size_t WS_W2T = WS_B1P + 4096;
constexpr size_t WS_PWT = 512 * 1024;
constexpr size_t WS_W1T = 1 * MiB;
constexpr size_t WS_WBT = 3 * MiB;
constexpr size_t WS_WOT = 7 * MiB;
constexpr size_t WS_WIN = 11 * MiB;
constexpr size_t WS_RSTD = 41 * MiB;
constexpr size_t WS_CFOX = 42 * MiB;
constexpr size_t WS_KC = 43 * MiB;
constexpr size_t WS_VCT = 44 * MiB;
constexpr size_t WS_VT = 45 * MiB;
constexpr size_t SZ_VT = (size_t)6 * GB * 64 * T * 2;
constexpr size_t WS_XB = WS_VT + SZ_VT;
#if NGROUP == 1
constexpr size_t WS_AB = WS_XB;
constexpr size_t WS_PROJ = WS_XB + (size_t)MG * DM * 2;
constexpr size_t WS_TOT = WS_PROJ;
#else
constexpr size_t WS_AB = WS_XB + (size_t)MG * DM * 2;
constexpr size_t WS_TOT = WS_AB + (size_t)MG * DM * 2;
constexpr size_t WS_PROJ = WS_TOT + (size_t)MG * DM * 2;
#endif
constexpr size_t WS_GATES = WS_PROJ + (size_t)MG * NP * 2;
constexpr size_t WS_END = WS_GATES + (size_t)MG * NGATE;
static_assert(WS_END <= (size_t)1024 * MiB, "workspace map exceeds 1 GiB");

constexpr int LDS_BYTES = 147456;
constexpr int AL_K = 0, AL_V = 18432, AL_CK = 36864, AL_U = 37376, AL_KC = 40960, AL_VC = 77824, AL_IMP = 111616, AL_SEL = 128256;

__device__ __forceinline__ float bf2f(unsigned short v) { return __uint_as_float((unsigned)v << 16); }
__device__ __forceinline__ unsigned pk2(float lo, float hi) { f32x2_t v = {lo, hi}; bf16x2_t b = __builtin_convertvector(v, bf16x2_t); return __builtin_bit_cast(unsigned, b); }
__device__ __forceinline__ unsigned short f2bf(float f) { return (unsigned short)(pk2(f, 0.f) & 0xffffu); }
__device__ __forceinline__ float lo16(unsigned w) { return __uint_as_float(w << 16); }
__device__ __forceinline__ float hi16(unsigned w) { return __uint_as_float(w & 0xffff0000u); }
__device__ __forceinline__ float fexp2(float x) { return __builtin_amdgcn_exp2f(x); }
__device__ __forceinline__ float frcp(float x) { return __builtin_amdgcn_rcpf(x); }
__device__ __forceinline__ float sigmoidf_(float x) { return frcp(1.f + fexp2(-x * LOG2E)); }
__device__ __forceinline__ float siluf_(float x) { return x * sigmoidf_(x); }
__device__ __forceinline__ float wave_sum(float v) {
#pragma unroll
  for (int o = 1; o < 64; o <<= 1) v += __shfl_xor(v, o);
  return v;
}
#define LDS_BARRIER() do { asm volatile("s_waitcnt lgkmcnt(0)" ::: "memory"); __builtin_amdgcn_s_barrier(); asm volatile("" ::: "memory"); } while (0)
__device__ __forceinline__ int crow(int r, int hi) { return (r & 3) + 8 * (r >> 2) + 4 * hi; }

struct EpiA {
  static constexpr bool PERM = true, AFTER_DRAIN = false;
  bf16_t* proj; unsigned char* gates;
  __device__ __forceinline__ void operator()(const pg8::f32x4 (&acc)[2][2][4][2], const pg8::Unit& u, int wr, int wc, int fr, int fq) const {
    const int row0 = u.pm * 256 + wr * 64 + fr;
    const bool isg = u.pn >= (NP / 256);
    if (!isg) {
      const int col0 = u.pn * 256 + wc * 32 + 8 * fq;
#pragma unroll
      for (int ai = 0; ai < 2; ++ai)
#pragma unroll
        for (int m = 0; m < 4; ++m) {
          bf16_t* rowp = proj + (size_t)(row0 + ai * 128 + m * 16) * NP + col0;
#pragma unroll
          for (int bj = 0; bj < 2; ++bj) {
            const pg8::f32x4 v0 = acc[ai][bj][m][0], v1 = acc[ai][bj][m][1];
            u32x4 w; w.x = pk2(v0[0], v0[1]); w.y = pk2(v0[2], v0[3]); w.z = pk2(v1[0], v1[1]); w.w = pk2(v1[2], v1[3]);
            *(u32x4*)(rowp + bj * 128) = w;
          }
        }
    } else {
      const int col0 = (u.pn - NP / 256) * 256 + wc * 32 + 8 * fq;
#pragma unroll
      for (int ai = 0; ai < 2; ++ai)
#pragma unroll
        for (int m = 0; m < 4; ++m) {
          unsigned char* rowp = gates + (size_t)(row0 + ai * 128 + m * 16) * NGATE + col0;
#pragma unroll
          for (int bj = 0; bj < 2; ++bj) {
            const pg8::f32x4 v0 = acc[ai][bj][m][0], v1 = acc[ai][bj][m][1];
            u32x2 w; w.x = 0u; w.y = 0u;
#pragma unroll
            for (int e = 0; e < 4; ++e) {
              w.x = __builtin_amdgcn_cvt_pk_u8_f32(sigmoidf_(v0[e]) * 255.0f, e, w.x);
              w.y = __builtin_amdgcn_cvt_pk_u8_f32(sigmoidf_(v1[e]) * 255.0f, e, w.y);
            }
            *(u32x2*)(rowp + bj * 128) = w;
          }
        }
    }
  }
};
struct EpiD2 {
  static constexpr bool PERM = true, AFTER_DRAIN = false;
  const float* xin; float* xout;
  __device__ __forceinline__ void operator()(const pg8::f32x4 (&acc)[2][2][4][2], const pg8::Unit& u, int wr, int wc, int fr, int fq) const {
    const int row0 = u.pm * 256 + wr * 64 + fr, col0 = u.pn * 256 + wc * 32 + 8 * fq;
#pragma unroll
    for (int ai = 0; ai < 2; ++ai)
#pragma unroll
      for (int m = 0; m < 4; ++m) {
        const size_t off = (size_t)(row0 + ai * 128 + m * 16) * 1024 + col0;
#pragma unroll
        for (int bj = 0; bj < 2; ++bj) {
          const pg8::f32x4 x0 = *(const pg8::f32x4*)(xin + off + bj * 128), x1 = *(const pg8::f32x4*)(xin + off + bj * 128 + 4);
          *(pg8::f32x4*)(xout + off + bj * 128) = x0 + acc[ai][bj][m][0];
          *(pg8::f32x4*)(xout + off + bj * 128 + 4) = x1 + acc[ai][bj][m][1];
        }
        asm volatile("" ::: "memory");
      }
  }
};
struct Args {
  const float* x; const float* norm_g; const float* w_in; const float* fox_f_bias; const float* cmp_pos; const float* cmp_w1; const float* cmp_b1;
  const float* cmp_w2; const float* cmp_b2; const float* pool_w; const float* pool_scale; const float* conv_w; const float* w_branch; const float* w_out;
  const float* final_g; float* out; unsigned char* ws;
};

__device__ __forceinline__ int win_srccol(int n) {
  if (n < 640) return n;
  if (n < 2432) return n + 12;
  if (n < 3456) return n + 16;
  if (n < 3468) return 640 + (n - 3456);
  if (n < 3472) return 2444 + (n - 3468);
  if (n < NP) return -1;
  return 3472 + (n - NP);
}

__device__ __forceinline__ void p0_prologue(const Args& a, int gt, int ngt) {
  unsigned char* ws = a.ws;
  {
    bf16_t* dst = (bf16_t*)(ws + WS_WIN);
    const int total = DEPTH * NTOT * (DM / 8);
    for (int it = gt; it < total; it += ngt) {
      const int n = it % NTOT, r = it / NTOT, kc = r % (DM / 8), l = r / (DM / 8);
      const int sc = win_srccol(n);
      const float qs = (n < 256 || (n >= C_FQ && n < C_FQ + 256)) ? QS : 1.f;
      float v[8];
#pragma unroll
      for (int j = 0; j < 8; ++j) { const int k = kc * 8 + j; v[j] = (sc < 0) ? 0.f : a.w_in[((size_t)l * DM + k) * DIN + sc] * a.norm_g[l * DM + k] * qs; }
      u32x4 w; w.x = pk2(v[0], v[1]); w.y = pk2(v[2], v[3]); w.z = pk2(v[4], v[5]); w.w = pk2(v[6], v[7]);
      *(u32x4*)(dst + ((size_t)l * NTOT + n) * DM + kc * 8) = w;
    }
  }
  {
    bf16_t* dst = (bf16_t*)(ws + WS_WBT);
    const int total = 8 * 1024 * 32;
    for (int it = gt; it < total; it += ngt) {
      const int n = it % 1024, r = it / 1024, kc = r % 32, mi = r / 32;
      const float* src = a.w_branch + (size_t)mi * 256 * 1024;
      float v[8];
#pragma unroll
      for (int j = 0; j < 8; ++j) v[j] = src[(size_t)(kc * 8 + j) * 1024 + n];
      u32x4 w; w.x = pk2(v[0], v[1]); w.y = pk2(v[2], v[3]); w.z = pk2(v[4], v[5]); w.w = pk2(v[6], v[7]);
      *(u32x4*)(dst + ((size_t)mi * 1024 + n) * 256 + kc * 8) = w;
    }
  }
  {
    bf16_t* dst = (bf16_t*)(ws + WS_WOT);
    const int total = 2 * 1024 * 128;
    for (int it = gt; it < total; it += ngt) {
      const int n = it % 1024, r = it / 1024, kc = r % 128, l = r / 128;
      const float* src = a.w_out + (size_t)l * 1024 * 1024;
      float v[8];
#pragma unroll
      for (int j = 0; j < 8; ++j) v[j] = src[(size_t)(kc * 8 + j) * 1024 + n] * (1.0f / 255.0f);
      u32x4 w; w.x = pk2(v[0], v[1]); w.y = pk2(v[2], v[3]); w.z = pk2(v[4], v[5]); w.w = pk2(v[6], v[7]);
      *(u32x4*)(dst + ((size_t)l * 1024 + n) * 1024 + kc * 8) = w;
    }
  }
  {
    bf16_t* dst = (bf16_t*)(ws + WS_W1T);
    const int total = 4 * 128 * 256;
    for (int it = gt; it < total; it += ngt) {
      const int c = it % 128, r = it / 128, kc = r % 256, m4 = r / 256;
      const float* src = a.cmp_w1 + (size_t)m4 * 2048 * 128;
      float v[8];
#pragma unroll
      for (int j = 0; j < 8; ++j) v[j] = src[(size_t)(kc * 8 + j) * 128 + c];
      u32x4 w; w.x = pk2(v[0], v[1]); w.y = pk2(v[2], v[3]); w.z = pk2(v[4], v[5]); w.w = pk2(v[6], v[7]);
      *(u32x4*)(dst + ((size_t)m4 * 128 + c) * 2048 + kc * 8) = w;
    }
  }
  {
    bf16_t* dst = (bf16_t*)(ws + WS_W2T);
    const int total = 4 * 64 * 16;
    for (int it = gt; it < total; it += ngt) {
      const int d = it % 64, r = it / 64, kc = r % 16, m4 = r / 16;
      const float* src = a.cmp_w2 + (size_t)m4 * 128 * 64;
      float v[8];
#pragma unroll
      for (int j = 0; j < 8; ++j) v[j] = src[(size_t)(kc * 8 + j) * 64 + d];
      u32x4 w; w.x = pk2(v[0], v[1]); w.y = pk2(v[2], v[3]); w.z = pk2(v[4], v[5]); w.w = pk2(v[6], v[7]);
      *(u32x4*)(dst + ((size_t)m4 * 64 + d) * 128 + kc * 8) = w;
    }
  }
  {
    bf16_t* dst = (bf16_t*)(ws + WS_PWT);
    const int total = 8 * 64 * 8;
    for (int it = gt; it < total; it += ngt) {
      const int d = it % 64, r = it / 64, kc = r % 8, lg = r / 8;
      const float* src = a.pool_w + (size_t)lg * 4096;
      float v[8];
#pragma unroll
      for (int j = 0; j < 8; ++j) v[j] = src[(size_t)(kc * 8 + j) * 64 + d];
      u32x4 w; w.x = pk2(v[0], v[1]); w.y = pk2(v[2], v[3]); w.z = pk2(v[4], v[5]); w.w = pk2(v[6], v[7]);
      *(u32x4*)(dst + ((size_t)lg * 64 + d) * 64 + kc * 8) = w;
    }
  }
  {
    float* dst = (float*)(ws + WS_B1P);
    const int gw = gt >> 6, ngw = ngt >> 6, lane = gt & 63;
    for (int o = gw; o < 512; o += ngw) {
      const int c = o % 128, m4 = o / 128;
      const float* w1 = a.cmp_w1 + (size_t)m4 * 2048 * 128; const float* pos = a.cmp_pos + (size_t)m4 * 2048;
      float s = 0.f;
      for (int kk = lane; kk < 2048; kk += 64) s += pos[kk] * w1[(size_t)kk * 128 + c];
      s = wave_sum(s);
      if (lane == 0) dst[o] = s + a.cmp_b1[m4 * 128 + c];
    }
  }
  {
    float* tab = (float*)(ws + WS_TAB);
    for (int it = gt; it < T * 8; it += ngt) {
      const int i = it & 7, t = it >> 3;
      const float inv = powf(500000.0f, -(float)i / 8.0f);
      const float ang = (float)t * inv;
      double rev = (double)ang * 0.15915494309189535; rev -= rint(rev);
      const float rv = (float)rev;
      tab[it * 2] = __builtin_amdgcn_cosf(rv); tab[it * 2 + 1] = __builtin_amdgcn_sinf(rv);
    }
  }
  if (gt < 64) ((unsigned*)(ws + WS_CTL))[gt] = 0u;
}

__device__ __forceinline__ void phase_rows(const float* __restrict__ xin, bf16_t* __restrict__ xb, float* rstd, int M, int gw, int ngw, int lane) {
  (void)rstd;
  for (int m0 = gw * 4; m0 < M; m0 += ngw * 4) {
    f32x4 v[4][4];
#pragma unroll
    for (int r = 0; r < 4; ++r) { const f32x4* xr = (const f32x4*)(xin + (size_t)(m0 + r) * DM) + lane;
#pragma unroll
      for (int j = 0; j < 4; ++j) v[r][j] = xr[64 * j]; }
#pragma unroll
    for (int r = 0; r < 4; ++r) {
      float s = 0.f;
#pragma unroll
      for (int j = 0; j < 4; ++j) s += (v[r][j].x * v[r][j].x + v[r][j].y * v[r][j].y) + (v[r][j].z * v[r][j].z + v[r][j].w * v[r][j].w);
      s = wave_sum(s);
      const float rs = 1.0f / sqrtf(s * (1.f / DM) + 1e-6f);
      u32x2* o = (u32x2*)(xb + (size_t)(m0 + r) * DM) + lane;
#pragma unroll
      for (int j = 0; j < 4; ++j) { u32x2 w; w.x = pk2(v[r][j].x * rs, v[r][j].y * rs); w.y = pk2(v[r][j].z * rs, v[r][j].w * rs); o[64 * j] = w; }
    }
  }
}
__device__ __forceinline__ void phase_final_norm(float* xio, const float* __restrict__ g, int M, int gw, int ngw, int lane) {
  f32x4 gg[4];
#pragma unroll
  for (int j = 0; j < 4; ++j) gg[j] = ((const f32x4*)g)[64 * j + lane];
  for (int m0 = gw * 4; m0 < M; m0 += ngw * 4) {
    f32x4 v[4][4];
#pragma unroll
    for (int r = 0; r < 4; ++r) { const f32x4* xr = (const f32x4*)(xio + (size_t)(m0 + r) * DM) + lane;
#pragma unroll
      for (int j = 0; j < 4; ++j) v[r][j] = xr[64 * j]; }
#pragma unroll
    for (int r = 0; r < 4; ++r) {
      float s = 0.f;
#pragma unroll
      for (int j = 0; j < 4; ++j) s += (v[r][j].x * v[r][j].x + v[r][j].y * v[r][j].y) + (v[r][j].z * v[r][j].z + v[r][j].w * v[r][j].w);
      s = wave_sum(s);
      const float rs = 1.0f / sqrtf(s * (1.f / DM) + 1e-6f);
      f32x4* xr = (f32x4*)(xio + (size_t)(m0 + r) * DM) + lane;
#pragma unroll
      for (int j = 0; j < 4; ++j) xr[64 * j] = v[r][j] * rs * gg[j];
    }
  }
}

__device__ __forceinline__ void b1_rope(bf16_t* proj, const float* tab, int gt, int ngt) {
  const int total = MG * 8;
  for (int it = gt; it < total; it += ngt) {
    const int tok = it >> 3, slot = it & 7; if (slot >= 6) continue;
    const int col = (slot < 4 ? C_Q + slot * 64 : (slot == 4 ? C_KS : C_KW));
    const int t = tok & (T - 1);
    u32x4* p = (u32x4*)(proj + (size_t)tok * NP + col);
    const u32x4 a = p[0], b = p[1];
    const f32x4* tb = (const f32x4*)(tab + (size_t)t * 16);
    const f32x4 t0 = tb[0], t1 = tb[1], t2 = tb[2], t3 = tb[3];
    const float x1[8] = {lo16(a.x), hi16(a.x), lo16(a.y), hi16(a.y), lo16(a.z), hi16(a.z), lo16(a.w), hi16(a.w)};
    const float x2[8] = {lo16(b.x), hi16(b.x), lo16(b.y), hi16(b.y), lo16(b.z), hi16(b.z), lo16(b.w), hi16(b.w)};
    const float cs[8] = {t0.x, t0.z, t1.x, t1.z, t2.x, t2.z, t3.x, t3.z}, sn[8] = {t0.y, t0.w, t1.y, t1.w, t2.y, t2.w, t3.y, t3.w};
    float y1[8], y2[8];
#pragma unroll
    for (int i = 0; i < 8; ++i) { y1[i] = x1[i] * cs[i] - x2[i] * sn[i]; y2[i] = x2[i] * cs[i] + x1[i] * sn[i]; }
    u32x4 oa, ob; oa.x = pk2(y1[0], y1[1]); oa.y = pk2(y1[2], y1[3]); oa.z = pk2(y1[4], y1[5]); oa.w = pk2(y1[6], y1[7]);
    ob.x = pk2(y2[0], y2[1]); ob.y = pk2(y2[2], y2[3]); ob.z = pk2(y2[4], y2[5]); ob.w = pk2(y2[6], y2[7]);
    p[0] = oa; p[1] = ob;
  }
}
__device__ __forceinline__ void b2_vtrans(const bf16_t* __restrict__ proj, bf16_t* __restrict__ vt, LAS unsigned char* lds, int gw, int ngw, int wid, int lane) {
  (void)lds; (void)wid;
  const int dblk = lane & 7, tblk = lane >> 3;
  const int total = 6 * GB * 64;
#pragma unroll 2
  for (int it = gw; it < total; it += ngw) {
    const int tt = it & 63, r = it >> 6, b = r % GB, src = r / GB;
    const int col = (src == 0) ? C_VS : (src == 1 ? C_VW : C_FV + (src - 2) * 64);
    const bf16_t* g = proj + (size_t)(b * T + tt * 64 + tblk * 8) * NP + col + dblk * 8;
    u32x4 a[8];
#pragma unroll
    for (int rr = 0; rr < 8; ++rr) a[rr] = *(const u32x4*)(g + (size_t)rr * NP);
    bf16_t* o = vt + ((size_t)(src * GB + b) * 64 + dblk * 8) * T + tt * 64 + tblk * 8;
#pragma unroll
    for (int i = 0; i < 8; ++i) {
      u32x4 w;
#pragma unroll
      for (int k = 0; k < 4; ++k) {
        const unsigned lo = a[2 * k][i >> 1], hi = a[2 * k + 1][i >> 1];
        w[k] = (i & 1) ? ((lo >> 16) | (hi & 0xffff0000u)) : ((lo & 0xffffu) | (hi << 16));
      }
      *(u32x4*)(o + (size_t)i * T) = w;
    }
  }
}
__device__ __forceinline__ float logsig(float z) { return fminf(z, 0.f) - __builtin_amdgcn_logf(1.f + fexp2(-fabsf(z) * LOG2E)) * 0.6931471805599453f; }
__device__ __forceinline__ void b3_foxcum(const bf16_t* proj, const float* fbias, float* c2, LAS unsigned char* lds, int tid, int wid, int lane) {
  LAS float* wtot = (LAS float*)(lds + 140 * 1024);
  const float b0 = fbias[0], b1 = fbias[1], b2 = fbias[2], b3 = fbias[3];
  for (int bb = (int)(gridDim.x - 1 - blockIdx.x); bb < GB; bb += gridDim.x) {
    const bf16_t* p = proj + (size_t)(bb * T + tid * 8) * NP + C_SM + 12;
    u32x2 raw[8];
#pragma unroll
    for (int j = 0; j < 8; ++j) raw[j] = *(const u32x2*)(p + (size_t)j * NP);
    float v[8][4]; float s[4] = {0.f, 0.f, 0.f, 0.f};
#pragma unroll
    for (int j = 0; j < 8; ++j) {
      s[0] += logsig(lo16(raw[j].x) + b0); v[j][0] = s[0];
      s[1] += logsig(hi16(raw[j].x) + b1); v[j][1] = s[1];
      s[2] += logsig(lo16(raw[j].y) + b2); v[j][2] = s[2];
      s[3] += logsig(hi16(raw[j].y) + b3); v[j][3] = s[3];
    }
    float incl[4];
#pragma unroll
    for (int h = 0; h < 4; ++h) {
      float x = s[h];
#pragma unroll
      for (int o = 1; o < 64; o <<= 1) { const float y = __shfl_up(x, o); if (lane >= o) x += y; }
      incl[h] = x;
      if (lane == 63) wtot[wid * 4 + h] = x;
    }
    __syncthreads();
#pragma unroll
    for (int h = 0; h < 4; ++h) {
      float pre = incl[h] - s[h];
      for (int w = 0; w < wid; ++w) pre += wtot[w * 4 + h];
      float* o = c2 + (size_t)(bb * 4 + h) * T + tid * 8;
      f32x4 o0, o1;
      o0.x = (pre + v[0][h]) * LOG2E; o0.y = (pre + v[1][h]) * LOG2E; o0.z = (pre + v[2][h]) * LOG2E; o0.w = (pre + v[3][h]) * LOG2E;
      o1.x = (pre + v[4][h]) * LOG2E; o1.y = (pre + v[5][h]) * LOG2E; o1.z = (pre + v[6][h]) * LOG2E; o1.w = (pre + v[7][h]) * LOG2E;
      *(f32x4*)o = o0; *(f32x4*)(o + 4) = o1;
    }
    __syncthreads();
  }
}
__device__ __forceinline__ void b7_knorm(const bf16_t* __restrict__ proj, float* __restrict__ kn, int gw, int ngw, int lane) {
  const int total = GB * 4 * 64;
  for (int it = gw; it < total; it += ngw) {
    const int j = it & 63, h = (it >> 6) & 3, b = it >> 8;
    const u32x4* p = (const u32x4*)(proj + (size_t)(b * T + j * 64 + lane) * NP + C_FK + h * 64);
    float ss = 0.f;
#pragma unroll
    for (int c = 0; c < 8; ++c) { const u32x4 v = p[c];
      const float f[8] = {lo16(v.x), hi16(v.x), lo16(v.y), hi16(v.y), lo16(v.z), hi16(v.z), lo16(v.w), hi16(v.w)};
#pragma unroll
      for (int e = 0; e < 8; ++e) ss += f[e] * f[e]; }
#pragma unroll
    for (int o = 1; o < 64; o <<= 1) ss = fmaxf(ss, __shfl_xor(ss, o));
    if (lane == 0) kn[it] = sqrtf(ss) * 1.001f;
  }
}
__device__ __forceinline__ void b4_compress(const bf16_t* proj, const bf16_t* w1T, const bf16_t* w2T, const float* b1p, const float* b2, const float* tab,
                                            bf16_t* kc, bf16_t* vcT, LAS unsigned char* lds, int tid, int wid, int lane) {
  const int r32 = lane & 31, hi = lane >> 5;
  LAS float* hid = (LAS float*)lds;
  LAS bf16_t* hb = (LAS bf16_t*)(lds + 2 * 32 * 132 * 4);
  LAS float* ost = (LAS float*)(lds + 2 * 32 * 132 * 4 + 32 * 136 * 2);
  for (int un = blockIdx.x; un < GB * 16; un += gridDim.x) {
    const int rt = un & 7, kv = (un >> 3) & 1, b = un >> 4;
    const int ct = wid & 3, kh = wid >> 2;
    const int n = rt * 32 + r32;
    const bf16_t* arow = proj + (size_t)(b * T + 16 * n) * NP + (kv ? C_VC : C_KC);
    const bf16_t* brow = w1T + ((size_t)kv * 128 + ct * 32 + r32) * 2048;
    f32x16 acc = {};
#pragma unroll 1
    for (int ks0 = 0; ks0 < 64; ks0 += 8) {
      bf16x8 af[8], bfr[8];
#pragma unroll
      for (int u = 0; u < 8; ++u) {
        const int kk = kh * 1024 + (ks0 + u) * 16 + hi * 8;
        af[u] = bf16x8{};
        if (n < 255) af[u] = *(const bf16x8*)(arow + (size_t)(kk >> 6) * NP + (kk & 63));
        bfr[u] = *(const bf16x8*)(brow + kk);
      }
#pragma unroll
      for (int u = 0; u < 8; ++u) acc = __builtin_amdgcn_mfma_f32_32x32x16_bf16(af[u], bfr[u], acc, 0, 0, 0);
    }
#pragma unroll
    for (int r = 0; r < 16; ++r) hid[(kh * 32 + crow(r, hi)) * 132 + ct * 32 + r32] = acc[r];
    __syncthreads();
    for (int e = tid; e < 32 * 128; e += 512) { const int rr = e >> 7, c = e & 127;
      const float v = hid[rr * 132 + c] + hid[(32 + rr) * 132 + c] + b1p[kv * 128 + c];
      hb[rr * 136 + c] = f2bf(siluf_(v)); }
    __syncthreads();
    if (wid < 2) {
      const int dt = wid; f32x16 a2 = {};
#pragma unroll
      for (int k0 = 0; k0 < 8; ++k0) {
        const bf16x8 af = *(const LAS bf16x8*)(hb + r32 * 136 + k0 * 16 + hi * 8);
        const bf16x8 bf = *(const bf16x8*)(w2T + ((size_t)kv * 64 + dt * 32 + r32) * 128 + k0 * 16 + hi * 8);
        a2 = __builtin_amdgcn_mfma_f32_32x32x16_bf16(af, bf, a2, 0, 0, 0);
      }
      const float bb = b2[kv * 64 + dt * 32 + r32];
#pragma unroll
      for (int r = 0; r < 16; ++r) ost[crow(r, hi) * 65 + dt * 32 + r32] = a2[r] + bb;
    }
    __syncthreads();
    for (int e = tid; e < 32 * 64; e += 512) {
      if (kv == 0) { const int rr = e >> 6, d = e & 63; const int nn = rt * 32 + rr; float v = ost[rr * 65 + d];
        if (d < 16) { const int i = d & 7, pos = 16 * nn + 31; const int pc = pos < T ? pos : T - 1;
          const float c = tab[(pc * 8 + i) * 2], s = tab[(pc * 8 + i) * 2 + 1];
          const float x1 = ost[rr * 65 + i], x2 = ost[rr * 65 + i + 8];
          v = (d < 8) ? (x1 * c - x2 * s) : (x2 * c + x1 * s); }
        if (nn >= 255) v = 0.f;
        kc[((size_t)b * 256 + nn) * 64 + d] = f2bf(v);
      } else { const int d = e >> 5, rr = e & 31; const int nn = rt * 32 + rr; float v = ost[rr * 65 + d]; if (nn >= 255) v = 0.f;
        vcT[((size_t)b * 64 + d) * 256 + nn] = f2bf(v); }
    }
    __syncthreads();
  }
}
__device__ __forceinline__ void b5_pool(const bf16_t* proj, const float* pool_w, const float* pool_scale, bf16_t* ab1, LAS unsigned char* lds, int tid) {
  LAS float* pl = (LAS float*)lds;
  for (int un = blockIdx.x; un < MG / 32; un += gridDim.x) {
    const int tl = tid >> 4, cg16 = tid & 15, tok = un * 32 + tl, t = tok & (T - 1);
    {
      const int c0 = cg16 * 16, gi = c0 >> 6, w = 2 << gi; const int cnt = (t + 1 < w) ? t + 1 : w;
      float s[16];
#pragma unroll
      for (int j = 0; j < 16; ++j) s[j] = 0.f;
      float u0[16];
      for (int k = 0; k < cnt; ++k) {
        const u32x4* p = (const u32x4*)(proj + (size_t)(tok - k) * NP + C_POOL + c0);
        const u32x4 a = p[0], b = p[1];
        const float v[16] = {lo16(a.x), hi16(a.x), lo16(a.y), hi16(a.y), lo16(a.z), hi16(a.z), lo16(a.w), hi16(a.w),
                             lo16(b.x), hi16(b.x), lo16(b.y), hi16(b.y), lo16(b.z), hi16(b.z), lo16(b.w), hi16(b.w)};
#pragma unroll
        for (int j = 0; j < 16; ++j) { s[j] += v[j]; if (k == 0) u0[j] = v[j]; }
      }
      const float ic = 1.0f / (float)cnt;
#pragma unroll
      for (int j = 0; j < 16; ++j) pl[tl * 260 + c0 + j] = s[j] * ic - u0[j];
    }
    __syncthreads();
    {
      const int gi = cg16 >> 2, d0 = (cg16 & 3) * 16;
      float o[16];
#pragma unroll
      for (int j = 0; j < 16; ++j) o[j] = 0.f;
      const float* wp = pool_w + (size_t)gi * 4096 + d0;
      for (int c = 0; c < 64; ++c) {
        const float pv = pl[tl * 260 + gi * 64 + c];
        const f32x4* w4 = (const f32x4*)(wp + c * 64);
#pragma unroll
        for (int q = 0; q < 4; ++q) { const f32x4 ww = w4[q]; o[4 * q] += pv * ww.x; o[4 * q + 1] += pv * ww.y; o[4 * q + 2] += pv * ww.z; o[4 * q + 3] += pv * ww.w; }
      }
      const int ch = gi * 64 + d0;
      const u32x4* gp = (const u32x4*)(proj + (size_t)tok * NP + C_GATE + 256 + ch);
      const u32x4 ga = gp[0], gb = gp[1];
      const float gv[16] = {lo16(ga.x), hi16(ga.x), lo16(ga.y), hi16(ga.y), lo16(ga.z), hi16(ga.z), lo16(ga.w), hi16(ga.w),
                            lo16(gb.x), hi16(gb.x), lo16(gb.y), hi16(gb.y), lo16(gb.z), hi16(gb.z), lo16(gb.w), hi16(gb.w)};
      float r[16];
#pragma unroll
      for (int j = 0; j < 16; ++j) r[j] = o[j] * pool_scale[ch + j] * siluf_(gv[j]);
      u32x4 w0, w1; w0.x = pk2(r[0], r[1]); w0.y = pk2(r[2], r[3]); w0.z = pk2(r[4], r[5]); w0.w = pk2(r[6], r[7]);
      w1.x = pk2(r[8], r[9]); w1.y = pk2(r[10], r[11]); w1.z = pk2(r[12], r[13]); w1.w = pk2(r[14], r[15]);
      u32x4* op = (u32x4*)(ab1 + (size_t)tok * 256 + ch); op[0] = w0; op[1] = w1;
    }
    __syncthreads();
  }
}
template <int W>
__device__ __forceinline__ void pool_window(const bf16_t* p, int t, float (&s)[8], float (&u0)[8]) {
  u32x4 v[W];
#pragma unroll
  for (int k = 0; k < W; ++k) v[k] = (k <= t) ? *(const u32x4*)(p - (size_t)k * NP) : u32x4{0u, 0u, 0u, 0u};
#pragma unroll
  for (int j = 0; j < 8; ++j) s[j] = 0.f;
#pragma unroll
  for (int k = 0; k < W; ++k) {
    const float f[8] = {lo16(v[k].x), hi16(v[k].x), lo16(v[k].y), hi16(v[k].y), lo16(v[k].z), hi16(v[k].z), lo16(v[k].w), hi16(v[k].w)};
#pragma unroll
    for (int j = 0; j < 8; ++j) { s[j] += f[j]; if (k == 0) u0[j] = f[j]; }
  }
}
__device__ __forceinline__ void b5_pool_mfma(const bf16_t* __restrict__ proj, const bf16_t* __restrict__ pwT, const float* __restrict__ pool_scale, bf16_t* __restrict__ ab1, int wid, int lane) {
  const int r32 = lane & 31, hi = lane >> 5, gi = wid & 3, th = wid >> 2, w = 2 << gi;
  bf16x8 wf[2][4];
#pragma unroll
  for (int dt = 0; dt < 2; ++dt)
#pragma unroll
    for (int k0 = 0; k0 < 4; ++k0) wf[dt][k0] = *(const bf16x8*)(pwT + ((size_t)gi * 64 + dt * 32 + r32) * 64 + k0 * 16 + hi * 8);
  for (int un = blockIdx.x; un < MG / 64; un += gridDim.x) {
    const int tok = un * 64 + th * 32 + r32, t = tok & (T - 1);
    const int cnt = (t + 1 < w) ? t + 1 : w; const float ic = 1.0f / (float)cnt;
    bf16x8 pf[4];
#pragma unroll
    for (int k0 = 0; k0 < 4; ++k0) {
      const bf16_t* p = proj + (size_t)tok * NP + C_POOL + gi * 64 + k0 * 16 + hi * 8;
      float s[8], u0[8];
      if (gi == 0) pool_window<2>(p, t, s, u0); else if (gi == 1) pool_window<4>(p, t, s, u0); else if (gi == 2) pool_window<8>(p, t, s, u0); else pool_window<16>(p, t, s, u0);
      u32x4 pw; pw.x = pk2(s[0] * ic - u0[0], s[1] * ic - u0[1]); pw.y = pk2(s[2] * ic - u0[2], s[3] * ic - u0[3]);
      pw.z = pk2(s[4] * ic - u0[4], s[5] * ic - u0[5]); pw.w = pk2(s[6] * ic - u0[6], s[7] * ic - u0[7]);
      pf[k0] = __builtin_bit_cast(bf16x8, pw);
    }
    f32x16 acc[2]; acc[0] = f32x16{}; acc[1] = f32x16{};
#pragma unroll
    for (int dt = 0; dt < 2; ++dt)
#pragma unroll
      for (int k0 = 0; k0 < 4; ++k0) acc[dt] = __builtin_amdgcn_mfma_f32_32x32x16_bf16(wf[dt][k0], pf[k0], acc[dt], 0, 0, 0);
#pragma unroll
    for (int dt = 0; dt < 2; ++dt)
#pragma unroll
      for (int g = 0; g < 4; ++g) {
        const int ch = gi * 64 + 32 * dt + 8 * g + 4 * hi;
        const u32x2 gw = *(const u32x2*)(proj + (size_t)tok * NP + C_GATE + 256 + ch);
        const f32x4 sc = *(const f32x4*)(pool_scale + ch);
        const float v0 = acc[dt][4 * g] * sc.x * siluf_(lo16(gw.x)), v1 = acc[dt][4 * g + 1] * sc.y * siluf_(hi16(gw.x));
        const float v2 = acc[dt][4 * g + 2] * sc.z * siluf_(lo16(gw.y)), v3 = acc[dt][4 * g + 3] * sc.w * siluf_(hi16(gw.y));
        u32x2 o; o.x = pk2(v0, v1); o.y = pk2(v2, v3); *(u32x2*)(ab1 + (size_t)tok * 256 + ch) = o;
      }
  }
}
__device__ __forceinline__ void b6_conv(const bf16_t* __restrict__ proj, const float* __restrict__ conv_w, bf16_t* __restrict__ ab2, int gt, int ngt) {
  const int total = MG * 32;
#pragma unroll 2
  for (int it = gt; it < total; it += ngt) {
    const int tok = it >> 5, c0 = (it & 31) * 8, t = tok & (T - 1);
    float y[8];
#pragma unroll
    for (int j = 0; j < 8; ++j) y[j] = 0.f;
#pragma unroll
    for (int k = 0; k < 3; ++k) {
      const int dt = 2 - k;
      if (t - dt >= 0) {
        const bf16_t* rp = proj + (size_t)(tok - dt) * NP;
        const u32x4 xv = *(const u32x4*)(rp + C_CX + c0), cv = *(const u32x4*)(rp + C_CC + c0);
        const float xs[8] = {lo16(xv.x), hi16(xv.x), lo16(xv.y), hi16(xv.y), lo16(xv.z), hi16(xv.z), lo16(xv.w), hi16(xv.w)};
        const float cs[8] = {lo16(cv.x), hi16(cv.x), lo16(cv.y), hi16(cv.y), lo16(cv.z), hi16(cv.z), lo16(cv.w), hi16(cv.w)};
#pragma unroll
        for (int j = 0; j < 8; ++j) y[j] += cs[j] * xs[j] * conv_w[k * 256 + c0 + j];
      }
    }
    const bf16_t* rp = proj + (size_t)tok * NP;
    const u32x4 bv = *(const u32x4*)(rp + C_CB + c0), gv = *(const u32x4*)(rp + C_GATE + 512 + c0);
    const float bs[8] = {lo16(bv.x), hi16(bv.x), lo16(bv.y), hi16(bv.y), lo16(bv.z), hi16(bv.z), lo16(bv.w), hi16(bv.w)};
    const float gs[8] = {lo16(gv.x), hi16(gv.x), lo16(gv.y), hi16(gv.y), lo16(gv.z), hi16(gv.z), lo16(gv.w), hi16(gv.w)};
    float r[8];
#pragma unroll
    for (int j = 0; j < 8; ++j) r[j] = bs[j] * y[j] * siluf_(gs[j]);
    u32x4 w; w.x = pk2(r[0], r[1]); w.y = pk2(r[2], r[3]); w.z = pk2(r[4], r[5]); w.w = pk2(r[6], r[7]);
    *(u32x4*)(ab2 + (size_t)tok * 256 + c0) = w;
  }
}
struct TileRegs { u32x4 k, v; float c; };
template <int MODE>
__device__ __forceinline__ void tile_load(TileRegs& R, const bf16_t* Kg, int kpitch, const bf16_t* Vtg, const float* cgl, int j, int tid) {
  const int row = tid >> 3, ch = tid & 7;
  R.k = *(const u32x4*)(Kg + (size_t)(64 * j + row) * kpitch + ch * 8);
  R.v = *(const u32x4*)(Vtg + (size_t)row * T + 64 * j + ch * 8);
  if (MODE == 0) { if (tid < 64) R.c = cgl[64 * j + tid]; }
}
template <int MODE>
__device__ __forceinline__ void tile_store(const TileRegs& R, LAS unsigned char* lds, int buf, int tid) {
  const int row = tid >> 3, ch = tid & 7;
  *(LAS u32x4*)(lds + AL_K + buf * 9216 + row * 144 + ch * 16) = R.k;
  *(LAS u32x4*)(lds + AL_V + buf * 9216 + row * 144 + ch * 16) = R.v;
  if (MODE == 0) { if (tid < 64) *(LAS float*)(lds + AL_CK + buf * 256 + tid * 4) = R.c; }
}
struct SoftState { float m, l; f32x16 o[2]; };
template <bool OFF = false>
__device__ __forceinline__ void softmax_pv(f32x16& s0, f32x16& s1, SoftState& st, const LAS unsigned char* Vt, int vstride, int kvoff, int r32, int hi) {
  float ra = __builtin_fmaxf(__builtin_fmaxf(s0[0], s0[1]), s1[0]), rb = __builtin_fmaxf(__builtin_fmaxf(s0[2], s0[3]), s1[1]);
  ra = __builtin_fmaxf(__builtin_fmaxf(ra, s1[2]), s1[3]);
#pragma unroll
  for (int r = 4; r < 16; r += 4) {
    ra = __builtin_fmaxf(__builtin_fmaxf(ra, s0[r]), s0[r + 1]); rb = __builtin_fmaxf(__builtin_fmaxf(rb, s0[r + 2]), s0[r + 3]);
    ra = __builtin_fmaxf(__builtin_fmaxf(ra, s1[r]), s1[r + 1]); rb = __builtin_fmaxf(__builtin_fmaxf(rb, s1[r + 2]), s1[r + 3]);
  }
  float rm = __builtin_fmaxf(ra, rb);
  rm = __builtin_fmaxf(rm, __shfl_xor(rm, 32));
  float ls = 0.f;
  if (OFF) {
    if (__any(rm > 8.0f)) {
      const float d = (rm > 8.0f) ? rm : 0.f;
      st.m += d;
      const float sc = fexp2(-d);
      st.l *= sc;
#pragma unroll
      for (int r = 0; r < 16; ++r) { st.o[0][r] *= sc; st.o[1][r] *= sc; s0[r] -= d; s1[r] -= d; }
    }
#pragma unroll
    for (int r = 0; r < 16; ++r) { s0[r] = fexp2(s0[r]); s1[r] = fexp2(s1[r]); ls += s0[r] + s1[r]; }
  } else {
    const float mnew = fmaxf(st.m, rm);
    const float mref = (mnew == NEG_INF) ? 0.f : mnew;
    if (__any(mnew > st.m)) {
      const float sc = fexp2(st.m - mref);
      st.l *= sc;
#pragma unroll
      for (int r = 0; r < 16; ++r) { st.o[0][r] *= sc; st.o[1][r] *= sc; }
    }
    st.m = mnew;
#pragma unroll
    for (int r = 0; r < 16; ++r) { s0[r] = fexp2(s0[r] - mref); s1[r] = fexp2(s1[r] - mref); ls += s0[r] + s1[r]; }
  }
  st.l += ls;
  bf16x8 pw[4];
#pragma unroll
  for (int jj = 0; jj < 2; ++jj) {
    u32x4 a, b;
    a.x = pk2(s0[8 * jj], s0[8 * jj + 1]); a.y = pk2(s0[8 * jj + 2], s0[8 * jj + 3]); a.z = pk2(s0[8 * jj + 4], s0[8 * jj + 5]); a.w = pk2(s0[8 * jj + 6], s0[8 * jj + 7]);
    b.x = pk2(s1[8 * jj], s1[8 * jj + 1]); b.y = pk2(s1[8 * jj + 2], s1[8 * jj + 3]); b.z = pk2(s1[8 * jj + 4], s1[8 * jj + 5]); b.w = pk2(s1[8 * jj + 6], s1[8 * jj + 7]);
    pw[jj] = __builtin_bit_cast(bf16x8, a); pw[2 + jj] = __builtin_bit_cast(bf16x8, b);
  }
#pragma unroll
  for (int dh = 0; dh < 2; ++dh) {
    const LAS unsigned char* vrow = Vt + (dh * 32 + r32) * vstride + kvoff + hi * 8;
#pragma unroll
    for (int jj = 0; jj < 4; ++jj) {
      const int kvb = 16 * (jj & 1) + 32 * (jj >> 1);
      const u32x2 lo = *(const LAS u32x2*)(vrow + kvb * 2), hh = *(const LAS u32x2*)(vrow + kvb * 2 + 16);
      u32x4 vv; vv.x = lo.x; vv.y = lo.y; vv.z = hh.x; vv.w = hh.y;
      st.o[dh] = __builtin_amdgcn_mfma_f32_32x32x16_bf16(__builtin_bit_cast(bf16x8, vv), pw[jj], st.o[dh], 0, 0, 0);
    }
  }
}
__device__ __forceinline__ void qk_tile_ini(f32x16& s0, f32x16& s1, const f32x16& ini, const LAS unsigned char* Kt, const bf16x8 (&qr)[4], int r32, int hi) {
  const LAS unsigned char* kb = Kt + r32 * 144 + hi * 16;
#pragma unroll
  for (int d0 = 0; d0 < 4; ++d0) {
    const bf16x8 k0 = *(const LAS bf16x8*)(kb + d0 * 32);
    const bf16x8 k1 = *(const LAS bf16x8*)(kb + 32 * 144 + d0 * 32);
    if (d0 == 0) { s0 = __builtin_amdgcn_mfma_f32_32x32x16_bf16(k0, qr[0], ini, 0, 0, 0); s1 = __builtin_amdgcn_mfma_f32_32x32x16_bf16(k1, qr[0], ini, 0, 0, 0); }
    else { s0 = __builtin_amdgcn_mfma_f32_32x32x16_bf16(k0, qr[d0], s0, 0, 0, 0); s1 = __builtin_amdgcn_mfma_f32_32x32x16_bf16(k1, qr[d0], s1, 0, 0, 0); }
  }
}
__device__ __forceinline__ void qk_tile(f32x16& s0, f32x16& s1, const LAS unsigned char* Kt, const bf16x8 (&qr)[4], int r32, int hi) {
  const LAS unsigned char* kb = Kt + r32 * 144 + hi * 16;
#pragma unroll
  for (int d0 = 0; d0 < 4; ++d0) {
    const bf16x8 k0 = *(const LAS bf16x8*)(kb + d0 * 32);
    const bf16x8 k1 = *(const LAS bf16x8*)(kb + 32 * 144 + d0 * 32);
    s0 = __builtin_amdgcn_mfma_f32_32x32x16_bf16(k0, qr[d0], s0, 0, 0, 0);
    s1 = __builtin_amdgcn_mfma_f32_32x32x16_bf16(k1, qr[d0], s1, 0, 0, 0);
  }
}
template <int MODE>
__device__ __forceinline__ void flash_loop(LAS unsigned char* lds, int jlo, int jhi, const bf16_t* Kg, int kpitch, const bf16_t* Vtg, const float* cgl,
                                           const bf16x8 (&qr)[4], int tq, int jw, unsigned sel_lo, unsigned sel_hi, float cq, SoftState& st, int tid, int r32, int hi) {
  TileRegs R;
  tile_load<MODE>(R, Kg, kpitch, Vtg, cgl, jlo, tid);
  tile_store<MODE>(R, lds, 0, tid);
  if (jlo < jhi) tile_load<MODE>(R, Kg, kpitch, Vtg, cgl, jlo + 1, tid);
  LDS_BARRIER();
  for (int j = jlo; j <= jhi; ++j) {
    const int buf = (j - jlo) & 1;
    if (j < jhi) tile_store<MODE>(R, lds, buf ^ 1, tid);
    if (j + 1 < jhi) tile_load<MODE>(R, Kg, kpitch, Vtg, cgl, j + 2, tid);
    if (j <= jw) {
      f32x16 s0, s1;
      if (MODE == 0) {
        const LAS unsigned char* ck = lds + AL_CK + buf * 256;
        const float cqm = cq - st.m;
#pragma unroll
        for (int g = 0; g < 4; ++g) {
          const f32x4 c0 = *(const LAS f32x4*)(ck + (8 * g + 4 * hi) * 4), c1 = *(const LAS f32x4*)(ck + (32 + 8 * g + 4 * hi) * 4);
#pragma unroll
          for (int e = 0; e < 4; ++e) { s0[4 * g + e] = cqm - c0[e]; s1[4 * g + e] = cqm - c1[e]; }
        }
        qk_tile(s0, s1, lds + AL_K + buf * 9216, qr, r32, hi);
      } else {
        float nm = -st.m;
        if (MODE == 1) { const unsigned bit = (j < 32) ? ((sel_lo >> j) & 1u) : ((sel_hi >> (j - 32)) & 1u); nm = bit ? nm : NEG_INF; }
        f32x16 ini;
#pragma unroll
        for (int r = 0; r < 16; ++r) ini[r] = nm;
        qk_tile_ini(s0, s1, ini, lds + AL_K + buf * 9216, qr, r32, hi);
      }
      const int lim_hi = tq - 64 * j;
      if (lim_hi < 63) {
#pragma unroll
        for (int r = 0; r < 16; ++r) { const int kv = crow(r, hi); if (kv > lim_hi) s0[r] = NEG_INF; if (kv + 32 > lim_hi) s1[r] = NEG_INF; }
      }
      if (MODE == 2) {
        const int lim_lo = tq - 512 - 64 * j;
        if (lim_lo >= 0) {
#pragma unroll
          for (int r = 0; r < 16; ++r) { const int kv = crow(r, hi); if (kv <= lim_lo) s0[r] = NEG_INF; if (kv + 32 <= lim_lo) s1[r] = NEG_INF; }
        }
      }
      softmax_pv<true>(s0, s1, st, lds + AL_V + buf * 9216, 144, 0, r32, hi);
    }
    LDS_BARRIER();
  }
}
__device__ __forceinline__ float merge_l(float l) { return l + __shfl_xor(l, 32); }

__device__ __forceinline__ void fox_unit(int b, int h, int qt, const bf16_t* proj, const bf16_t* vt, const float* c2, const float* kn, bf16_t* ab3, LAS unsigned char* lds, int tid, int wid, int lane) {
  const int r32 = lane & 31, hi = lane >> 5;
  const int q0 = qt * 256 + wid * 32, tq = q0 + r32;
  const size_t tok = (size_t)b * T + tq;
  bf16x8 qr[4];
#pragma unroll
  for (int d0 = 0; d0 < 4; ++d0) qr[d0] = *(const bf16x8*)(proj + tok * NP + C_FQ + h * 64 + d0 * 16 + hi * 8);
  const float* cgl = c2 + (size_t)(b * 4 + h) * T;
  const float cq = cgl[tq];
  SoftState st; st.m = 0.f; st.l = 0.f; st.o[0] = f32x16{}; st.o[1] = f32x16{};
  int jstart = 0;
  {
    float qq = 0.f;
#pragma unroll
    for (int d0 = 0; d0 < 4; ++d0) { const u32x4 w = __builtin_bit_cast(u32x4, qr[d0]);
      const float f[8] = {lo16(w.x), hi16(w.x), lo16(w.y), hi16(w.y), lo16(w.z), hi16(w.z), lo16(w.w), hi16(w.w)};
#pragma unroll
      for (int e = 0; e < 8; ++e) qq += f[e] * f[e]; }
    qq += __shfl_xor(qq, 32);
#pragma unroll
    for (int o = 1; o < 32; o <<= 1) qq = fmaxf(qq, __shfl_xor(qq, o));
    LAS float* red = (LAS float*)(lds + AL_U + 16);
    if (lane == 0) red[wid] = qq;
    __syncthreads();
    float qmax = red[0];
#pragma unroll
    for (int w = 1; w < 8; ++w) qmax = fmaxf(qmax, red[w]);
    qmax = sqrtf(qmax) * 1.001f;
    const int jhi_u = (qt * 256 + 255) >> 6;
    float kk = (lane <= jhi_u) ? kn[(size_t)(b * 4 + h) * 64 + lane] : 0.f;
    float kall = kk;
#pragma unroll
    for (int o = 1; o < 64; o <<= 1) kall = fmaxf(kall, __shfl_xor(kall, o));
    const float c_first = cgl[qt * 256];
    const float c_last = cgl[(lane <= jhi_u) ? (64 * lane + 63) : (T - 1)];
    const bool skip = (lane <= jhi_u) && (2.0f * qmax * kall + 44.0f + (c_first - c_last) < 0.f);
    const unsigned long long bal = __ballot(skip);
    jstart = (~bal == 0ull) ? 64 : (__ffsll((long long)~bal) - 1);
    if (jstart > (qt * 256) >> 6) jstart = (qt * 256) >> 6;
    __syncthreads();
  }
  flash_loop<0>(lds, jstart, (qt * 256 + 255) >> 6, proj + (size_t)b * T * NP + C_FK + h * 64, NP, vt + ((size_t)((2 + h) * GB + b) * 64) * T, cgl, qr, tq, q0 >> 6, 0u, 0u, cq, st, tid, r32, hi);
  const float inv = frcp(merge_l(st.l));
  const bf16_t* gp = proj + tok * NP + C_GATE + 768 + h * 64;
  bf16_t* op = ab3 + tok * 256 + h * 64;
#pragma unroll
  for (int dh = 0; dh < 2; ++dh)
#pragma unroll
    for (int g = 0; g < 4; ++g) {
      const int d = 32 * dh + 8 * g + 4 * hi;
      const u32x2 gw = *(const u32x2*)(gp + d);
      const float v0 = st.o[dh][4 * g] * inv * siluf_(lo16(gw.x)), v1 = st.o[dh][4 * g + 1] * inv * siluf_(hi16(gw.x));
      const float v2 = st.o[dh][4 * g + 2] * inv * siluf_(lo16(gw.y)), v3 = st.o[dh][4 * g + 3] * inv * siluf_(hi16(gw.y));
      u32x2 w; w.x = pk2(v0, v1); w.y = pk2(v2, v3); *(u32x2*)(op + d) = w;
    }
}

__device__ __forceinline__ void nsa_unit(int b, int qt, const bf16_t* proj, const bf16_t* vt, const bf16_t* kc, const bf16_t* vcT, bf16_t* ab0, LAS unsigned char* lds, int tid, int wid, int lane) {
  const int r32 = lane & 31, hi = lane >> 5, head = wid & 3, th = wid >> 2;
  const int q0 = qt * 64, ql = th * 32 + r32, tq = q0 + ql;
  const size_t tok = (size_t)b * T + tq;
#pragma unroll
  for (int i = 0; i < 4; ++i) { const int chn = tid + 512 * i; const int row = chn >> 3, c = chn & 7;
    *(LAS u32x4*)(lds + AL_KC + row * 144 + c * 16) = *(const u32x4*)(kc + ((size_t)b * 256 + row) * 64 + c * 8); }
#pragma unroll
  for (int i = 0; i < 4; ++i) { const int chn = tid + 512 * i; const int row = chn >> 5, c = chn & 31;
    *(LAS u32x4*)(lds + AL_VC + row * 528 + c * 16) = *(const u32x4*)(vcT + ((size_t)b * 64 + row) * 256 + c * 8); }
  LAS float* imp0 = (LAS float*)(lds + AL_IMP); LAS float* imp1 = (LAS float*)(lds + 0); LAS float* imp2 = (LAS float*)(lds + 16640); LAS float* imp3 = (LAS float*)(lds + 128768);
  const bool need_imp = qt >= 16;
  if (need_imp) { for (int e = tid; e < 64 * 65; e += 512) { imp0[e] = 0.f; imp1[e] = 0.f; imp2[e] = 0.f; imp3[e] = 0.f; } }
  LAS float* imp = (head == 0) ? imp0 : (head == 1) ? imp1 : (head == 2) ? imp2 : imp3;
  bf16x8 qr[4];
#pragma unroll
  for (int d0 = 0; d0 < 4; ++d0) qr[d0] = *(const bf16x8*)(proj + tok * NP + C_Q + head * 64 + d0 * 16 + hi * 8);
  __syncthreads();
  const int nmaxq = (tq - 31) >> 4;
  int ncnt = q0 / 16 + 3; if (ncnt > 255) ncnt = 255;
  const int ntc = (ncnt + 63) >> 6;
  float Bq;
  {
    LAS float* red8 = (LAS float*)(lds + AL_U + 128);
    float kq = 0.f;
    if (tid < 256) {
#pragma unroll
      for (int c = 0; c < 8; ++c) { const u32x4 v = *(const LAS u32x4*)(lds + AL_KC + tid * 144 + c * 16);
        const float f[8] = {lo16(v.x), hi16(v.x), lo16(v.y), hi16(v.y), lo16(v.z), hi16(v.z), lo16(v.w), hi16(v.w)};
#pragma unroll
        for (int e = 0; e < 8; ++e) kq += f[e] * f[e]; }
    }
#pragma unroll
    for (int o = 1; o < 64; o <<= 1) kq = fmaxf(kq, __shfl_xor(kq, o));
    if (lane == 0) red8[wid] = kq;
    __syncthreads();
    float kmax2 = red8[0];
#pragma unroll
    for (int w = 1; w < 8; ++w) kmax2 = fmaxf(kmax2, red8[w]);
    float qq = 0.f;
#pragma unroll
    for (int d0 = 0; d0 < 4; ++d0) { const u32x4 w = __builtin_bit_cast(u32x4, qr[d0]);
      const float f[8] = {lo16(w.x), hi16(w.x), lo16(w.y), hi16(w.y), lo16(w.z), hi16(w.z), lo16(w.w), hi16(w.w)};
#pragma unroll
      for (int e = 0; e < 8; ++e) qq += f[e] * f[e]; }
    qq += __shfl_xor(qq, 32);
    Bq = fminf(sqrtf(qq * kmax2) * 1.001f, 60.0f);
  }
  float l = 0.f;
  f32x16 oc[2]; oc[0] = f32x16{}; oc[1] = f32x16{};
  for (int jt = 0; jt < ntc; ++jt) {
    f32x16 s0 = {}, s1 = {};
    qk_tile(s0, s1, lds + AL_KC + jt * 64 * 144, qr, r32, hi);
    const int lim = nmaxq - 64 * jt;
#pragma unroll
    for (int r = 0; r < 16; ++r) { const int kv = crow(r, hi);
      s0[r] = (kv > lim) ? 0.f : fexp2(s0[r] - Bq); s1[r] = (kv + 32 > lim) ? 0.f : fexp2(s1[r] - Bq); l += s0[r] + s1[r]; }
    if (need_imp) {
      {
#pragma unroll
        for (int sub = 0; sub < 2; ++sub)
#pragma unroll
          for (int g = 0; g < 4; ++g) {
            const f32x16& s = sub ? s1 : s0;
            const int jg = 16 * jt + 8 * sub + 2 * g + hi;
            imp[ql * 65 + jg] += (s[4 * g] + s[4 * g + 1]) + (s[4 * g + 2] + s[4 * g + 3]);
          }
        asm volatile("s_waitcnt lgkmcnt(0)" ::: "memory");
#pragma unroll
        for (int sub = 0; sub < 2; ++sub)
#pragma unroll
          for (int g = 0; g < 4; ++g) {
            const f32x16& s = sub ? s1 : s0;
            const int jg = 16 * jt + 8 * sub + 2 * g + hi;
            if (jg + 1 < 64) imp[ql * 65 + jg + 1] += s[4 * g + 3];
          }
      }
      asm volatile("s_waitcnt lgkmcnt(0)" ::: "memory");
    }
    bf16x8 pw[4];
#pragma unroll
    for (int jj = 0; jj < 2; ++jj) {
      u32x4 a, bq;
      a.x = pk2(s0[8 * jj], s0[8 * jj + 1]); a.y = pk2(s0[8 * jj + 2], s0[8 * jj + 3]); a.z = pk2(s0[8 * jj + 4], s0[8 * jj + 5]); a.w = pk2(s0[8 * jj + 6], s0[8 * jj + 7]);
      bq.x = pk2(s1[8 * jj], s1[8 * jj + 1]); bq.y = pk2(s1[8 * jj + 2], s1[8 * jj + 3]); bq.z = pk2(s1[8 * jj + 4], s1[8 * jj + 5]); bq.w = pk2(s1[8 * jj + 6], s1[8 * jj + 7]);
      pw[jj] = __builtin_bit_cast(bf16x8, a); pw[2 + jj] = __builtin_bit_cast(bf16x8, bq);
    }
#pragma unroll
    for (int dh = 0; dh < 2; ++dh) {
      const LAS unsigned char* vrow = lds + AL_VC + (dh * 32 + r32) * 528 + jt * 128 + hi * 8;
#pragma unroll
      for (int jj = 0; jj < 4; ++jj) {
        const int kvb = 16 * (jj & 1) + 32 * (jj >> 1);
        const u32x2 lo = *(const LAS u32x2*)(vrow + kvb * 2), hh = *(const LAS u32x2*)(vrow + kvb * 2 + 16);
        u32x4 vv; vv.x = lo.x; vv.y = lo.y; vv.z = hh.x; vv.w = hh.y;
        oc[dh] = __builtin_amdgcn_mfma_f32_32x32x16_bf16(__builtin_bit_cast(bf16x8, vv), pw[jj], oc[dh], 0, 0, 0);
      }
    }
  }
  l = merge_l(l);
  const float linv = (l > 0.f) ? frcp(l) : 0.f;
#pragma unroll
  for (int r = 0; r < 16; ++r) { oc[0][r] *= linv; oc[1][r] *= linv; }
  LAS float* linvL = (LAS float*)(lds + AL_U + 256);
  if (hi == 0) linvL[head * 64 + ql] = linv;
  __syncthreads();
  LAS unsigned* selw = (LAS unsigned*)(lds + AL_SEL);
  if (qt + 1 <= 16) {
    if (tid < 64) { const unsigned long long mk = (qt + 1 >= 64) ? ~0ull : ((1ull << (qt + 1)) - 1ull); selw[tid * 2] = (unsigned)mk; selw[tid * 2 + 1] = (unsigned)(mk >> 32); }
  } else {
#pragma unroll 1
    for (int i = 0; i < 8; ++i) {
      const int qi = wid * 8 + i;
      const bool valid = lane <= qt, forced = (lane == 0) || (lane == qt) || (lane == qt - 1);
      float val = ((imp0[qi * 65 + lane] * linvL[qi] + imp1[qi * 65 + lane] * linvL[64 + qi]) + imp2[qi * 65 + lane] * linvL[128 + qi]) + imp3[qi * 65 + lane] * linvL[192 + qi];
      val = valid ? (forced ? val + 1.0e4f : val) : -1.0e30f;
      int rank = 0;
#pragma unroll 4
      for (int jj = 0; jj <= qt; ++jj) {
        const float o = __builtin_bit_cast(float, __builtin_amdgcn_readlane(__builtin_bit_cast(int, val), jj));
        rank += (o > val || (o == val && jj < lane)) ? 1 : 0;
      }
      const unsigned long long mk = __ballot(rank < 16);
      if (lane == 0) { selw[qi * 2] = (unsigned)mk; selw[qi * 2 + 1] = (unsigned)(mk >> 32); }
    }
  }
  __syncthreads();
  const unsigned sel_lo = selw[ql * 2], sel_hi = selw[ql * 2 + 1];
  const bf16_t* sm = proj + tok * NP + C_SM;
  const float g0 = sigmoidf_(bf2f(sm[head])), g1 = sigmoidf_(bf2f(sm[4 + head])), g2 = sigmoidf_(bf2f(sm[8 + head]));
  LAS float* stash = (LAS float*)(lds + AL_KC) + wid * 2048 + lane;
#pragma unroll
  for (int r = 0; r < 16; ++r) { stash[r * 64] = g0 * oc[0][r]; stash[(16 + r) * 64] = g0 * oc[1][r]; }
  f32x16 ot[2];
  {
    SoftState st; st.m = 0.f; st.l = 0.f; st.o[0] = f32x16{}; st.o[1] = f32x16{};
#ifndef NSA_NO_SEL
    flash_loop<1>(lds, 0, qt, proj + (size_t)b * T * NP + C_KS, NP, vt + ((size_t)(0 * GB + b) * 64) * T, nullptr, qr, tq, qt, sel_lo, sel_hi, 0.f, st, tid, r32, hi);
#endif
    const float sc = g1 * frcp(merge_l(st.l));
#pragma unroll
    for (int r = 0; r < 16; ++r) { stash[r * 64] += sc * st.o[0][r]; stash[(16 + r) * 64] += sc * st.o[1][r]; }
  }
  {
    SoftState st; st.m = 0.f; st.l = 0.f; st.o[0] = f32x16{}; st.o[1] = f32x16{};
#ifndef NSA_NO_WIN
    flash_loop<2>(lds, (qt >= 8) ? qt - 8 : 0, qt, proj + (size_t)b * T * NP + C_KW, NP, vt + ((size_t)(1 * GB + b) * 64) * T, nullptr, qr, tq, qt, 0u, 0u, 0.f, st, tid, r32, hi);
#endif
    const float sc = g2 * frcp(merge_l(st.l));
#pragma unroll
    for (int r = 0; r < 16; ++r) { ot[0][r] = stash[r * 64] + sc * st.o[0][r]; ot[1][r] = stash[(16 + r) * 64] + sc * st.o[1][r]; }
  }
  const bf16_t* gp = proj + tok * NP + C_GATE + head * 64;
  bf16_t* op = ab0 + tok * 256 + head * 64;
#pragma unroll
  for (int dh = 0; dh < 2; ++dh)
#pragma unroll
    for (int g = 0; g < 4; ++g) {
      const int d = 32 * dh + 8 * g + 4 * hi;
      const u32x2 gw = *(const u32x2*)(gp + d);
      const float v0 = ot[dh][4 * g] * siluf_(lo16(gw.x)), v1 = ot[dh][4 * g + 1] * siluf_(hi16(gw.x));
      const float v2 = ot[dh][4 * g + 2] * siluf_(lo16(gw.y)), v3 = ot[dh][4 * g + 3] * siluf_(hi16(gw.y));
      u32x2 w; w.x = pk2(v0, v1); w.y = pk2(v2, v3); *(u32x2*)(op + d) = w;
    }
  __syncthreads();
}
struct D1Regs { u32x4 w[4], a[2]; };
__device__ __forceinline__ void d1_load(D1Regs& R, const bf16_t* ab, const bf16_t* wbT, int pm, int pn, int s, unsigned goff) {
  const int i = s >> 2, kc = s & 3;
  const unsigned char* wbase = (const unsigned char*)(wbT + ((size_t)(i * 1024 + pn * 256)) * 256 + kc * 64);
  const unsigned char* abase = (const unsigned char*)(ab + ((size_t)i * MG + pm * 128) * 256 + kc * 64);
#pragma unroll
  for (int q = 0; q < 4; ++q) R.w[q] = *(const u32x4*)(wbase + q * 32768 + goff);
#pragma unroll
  for (int q = 0; q < 2; ++q) R.a[q] = *(const u32x4*)(abase + q * 32768 + goff);
}
__device__ __forceinline__ void d1_store(const D1Regs& R, LAS unsigned char* st, unsigned loff) {
#pragma unroll
  for (int q = 0; q < 4; ++q) *(LAS u32x4*)(st + q * 9216 + loff) = R.w[q];
#pragma unroll
  for (int q = 0; q < 2; ++q) *(LAS u32x4*)(st + 36864 + q * 9216 + loff) = R.a[q];
}
__device__ __forceinline__ void d1_compute(f32x16 (&acc)[2][2], const LAS unsigned char* st, int wn, int wm, int cperm, int r32, int hi) {
  const LAS unsigned char* wb = st + (wn * 64 + cperm) * 144 + hi * 16;
  const LAS unsigned char* abp = st + 36864 + (wm * 64 + r32) * 144 + hi * 16;
#pragma unroll
  for (int k16 = 0; k16 < 4; ++k16) {
    const bf16x8 w0 = *(const LAS bf16x8*)(wb + k16 * 32), w1 = *(const LAS bf16x8*)(wb + 32 * 144 + k16 * 32);
    const bf16x8 a0 = *(const LAS bf16x8*)(abp + k16 * 32), a1 = *(const LAS bf16x8*)(abp + 32 * 144 + k16 * 32);
    acc[0][0] = __builtin_amdgcn_mfma_f32_32x32x16_bf16(w0, a0, acc[0][0], 0, 0, 0);
    acc[0][1] = __builtin_amdgcn_mfma_f32_32x32x16_bf16(w0, a1, acc[0][1], 0, 0, 0);
    acc[1][0] = __builtin_amdgcn_mfma_f32_32x32x16_bf16(w1, a0, acc[1][0], 0, 0, 0);
    acc[1][1] = __builtin_amdgcn_mfma_f32_32x32x16_bf16(w1, a1, acc[1][1], 0, 0, 0);
  }
}
__device__ __forceinline__ void d1_compute_lite(f32x16 (&dum)[2], const LAS unsigned char* st, int wn, int wm, int cperm, int r32, int hi) {
  const LAS unsigned char* wb = st + (wn * 64 + cperm) * 144 + hi * 16;
  const LAS unsigned char* abp = st + 36864 + (wm * 64 + r32) * 144 + hi * 16;
#pragma unroll
  for (int k16 = 0; k16 < 4; ++k16) {
    const bf16x8 w0 = *(const LAS bf16x8*)(wb + k16 * 32), w1 = *(const LAS bf16x8*)(wb + 32 * 144 + k16 * 32);
    const bf16x8 a0 = *(const LAS bf16x8*)(abp + k16 * 32), a1 = *(const LAS bf16x8*)(abp + 32 * 144 + k16 * 32);
    dum[0] = __builtin_amdgcn_mfma_f32_32x32x16_bf16(w0, a0, dum[0], 0, 0, 0);
    dum[1] = __builtin_amdgcn_mfma_f32_32x32x16_bf16(w0, a1, dum[1], 0, 0, 0);
    dum[0] = __builtin_amdgcn_mfma_f32_32x32x16_bf16(w1, a0, dum[0], 0, 0, 0);
    dum[1] = __builtin_amdgcn_mfma_f32_32x32x16_bf16(w1, a1, dum[1], 0, 0, 0);
  }
}
__device__ __forceinline__ void d1_phase(const bf16_t* ab, const bf16_t* wbT, const unsigned char* gates, bf16_t* tot, LAS unsigned char* lds, int tid, int wid, int lane) {
  const int r32 = lane & 31, hi = lane >> 5, wm = wid & 1, wn = wid >> 1;
  const int cperm = (r32 & ~0xC) | ((r32 & 4) << 1) | ((r32 & 8) >> 1);
  constexpr int STG = 55296;
  const unsigned goff = (unsigned)((tid >> 3) * 512 + (tid & 7) * 16), loff = (unsigned)((tid >> 3) * 144 + (tid & 7) * 16);
  const int nunits = (MG / 128) * 4;
  const int G8 = gridDim.x >> 3, xcd = blockIdx.x & 7, jloc = blockIdx.x >> 3, upx = nunits >> 3;
#pragma unroll 1
  for (int ul = jloc; ul < upx; ul += G8) {
    const int un = xcd * upx + ul;
    const int pn = un & 3, pm = un >> 2;
    const unsigned char* gbase = gates + (size_t)(pm * 128) * NGATE + pn * 256;
    const unsigned ggo = (unsigned)((tid >> 4) * NGATE + (tid & 15) * 16), glo = (unsigned)((tid >> 4) * 264 + (tid & 15) * 16);
    f32x16 acc[2][2]; u32x4 tp[2][2][2];
#pragma unroll
    for (int x = 0; x < 2; ++x)
#pragma unroll
      for (int y = 0; y < 2; ++y) { acc[x][y] = f32x16{}; tp[x][y][0] = u32x4{0u, 0u, 0u, 0u}; tp[x][y][1] = u32x4{0u, 0u, 0u, 0u}; }
    D1Regs R0, R1;
    f32x16 dum[2];
    if (D1_DOUBLE) { dum[0] = f32x16{}; dum[1] = f32x16{}; }
    u32x4 gq[4];
#pragma unroll
    for (int q = 0; q < 4; ++q) gq[q] = *(const u32x4*)(gbase + (size_t)(q * 32) * NGATE + ggo);
    d1_load(R0, ab, wbT, pm, pn, 0, goff);
    d1_load(R1, ab, wbT, pm, pn, 1, goff);
    d1_store(R0, lds, loff);
    LDS_BARRIER();
#pragma unroll 1
    for (int i = 0; i < 4; ++i) {
      const int s0 = 4 * i;
      d1_load(R0, ab, wbT, pm, pn, s0 + 2, goff);
      d1_compute(acc, lds, wn, wm, cperm, r32, hi); if (D1_DOUBLE) d1_compute_lite(dum, lds, wn, wm, cperm, r32, hi);
      d1_store(R1, lds + STG, loff);
      LDS_BARRIER();
      {
        d1_load(R1, ab, wbT, pm, pn, s0 + 3, goff);
        d1_compute(acc, lds + STG, wn, wm, cperm, r32, hi); if (D1_DOUBLE) d1_compute_lite(dum, lds + STG, wn, wm, cperm, r32, hi);
#pragma unroll
        for (int q = 0; q < 4; ++q) *(LAS u32x4*)(lds + 2 * STG + q * 32 * 264 + glo) = gq[q];
        d1_store(R0, lds, loff);
      }
      LDS_BARRIER();
      if (i < 3) d1_load(R0, ab, wbT, pm, pn, s0 + 4, goff);
      d1_compute(acc, lds, wn, wm, cperm, r32, hi); if (D1_DOUBLE) d1_compute_lite(dum, lds, wn, wm, cperm, r32, hi);
      d1_store(R1, lds + STG, loff);
      LDS_BARRIER();
      if (i < 3) {
#pragma unroll
        for (int q = 0; q < 4; ++q) gq[q] = *(const u32x4*)(gbase + (size_t)(q * 32) * NGATE + (i + 1) * 1024 + ggo);
        d1_load(R1, ab, wbT, pm, pn, s0 + 5, goff);
      }
      d1_compute(acc, lds + STG, wn, wm, cperm, r32, hi); if (D1_DOUBLE) d1_compute_lite(dum, lds + STG, wn, wm, cperm, r32, hi);
#pragma unroll
      for (int tm = 0; tm < 2; ++tm)
#pragma unroll
        for (int tn = 0; tn < 2; ++tn)
#pragma unroll
          for (int p = 0; p < 2; ++p) {
            const u32x2 g = *(const LAS u32x2*)(lds + 2 * STG + (wm * 64 + tn * 32 + r32) * 264 + wn * 64 + tm * 32 + 16 * p + 8 * hi);
            const u32x4 t = tp[tm][tn][p]; const f32x16& c = acc[tm][tn];
            u32x4 o;
            o.x = pk2(lo16(t.x) + (float)(g.x & 0xffu) * c[8 * p + 0], hi16(t.x) + (float)((g.x >> 8) & 0xffu) * c[8 * p + 1]);
            o.y = pk2(lo16(t.y) + (float)((g.x >> 16) & 0xffu) * c[8 * p + 2], hi16(t.y) + (float)(g.x >> 24) * c[8 * p + 3]);
            o.z = pk2(lo16(t.z) + (float)(g.y & 0xffu) * c[8 * p + 4], hi16(t.z) + (float)((g.y >> 8) & 0xffu) * c[8 * p + 5]);
            o.w = pk2(lo16(t.w) + (float)((g.y >> 16) & 0xffu) * c[8 * p + 6], hi16(t.w) + (float)(g.y >> 24) * c[8 * p + 7]);
            tp[tm][tn][p] = o;
          }
#pragma unroll
      for (int x = 0; x < 2; ++x)
#pragma unroll
        for (int y = 0; y < 2; ++y) acc[x][y] = f32x16{};
      if (i < 3) d1_store(R0, lds, loff);
      LDS_BARRIER();
    }
    if (D1_DOUBLE) { asm volatile("" :: "v"(dum[0]), "v"(dum[1])); }
    bf16_t* trow = tot + (size_t)(pm * 128 + wm * 64 + r32) * 1024 + pn * 256 + wn * 64 + 8 * hi;
#pragma unroll
    for (int tm = 0; tm < 2; ++tm)
#pragma unroll
      for (int tn = 0; tn < 2; ++tn)
#pragma unroll
        for (int p = 0; p < 2; ++p) {
          *(u32x4*)(trow + (size_t)tn * 32 * 1024 + tm * 32 + 16 * p) = tp[tm][tn][p];
        }
  }
}
#define XB_TMO      128
#define XB_XCNT(j)  (256  + 64 * (j))
#define XB_XSUB(j)  (1280 + 64 * (j))
#define XB_XGEN(j)  (2304 + 64 * (j))
#define XB_TOP      3328
#define XB_TOPGEN   3392
#define XCD_BAR_WORDS 3456
#define XB_SPIN_CAP (1u << 18)

__device__ __forceinline__ unsigned xb_ld(unsigned* p)              { return __hip_atomic_load(p, __ATOMIC_RELAXED, __HIP_MEMORY_SCOPE_AGENT); }
__device__ __forceinline__ unsigned xb_add(unsigned* p, unsigned v) { return __hip_atomic_fetch_add(p, v, __ATOMIC_RELAXED, __HIP_MEMORY_SCOPE_AGENT); }
__device__ __forceinline__ unsigned xb_xcc_id() { return (unsigned)__builtin_amdgcn_s_getreg((3 << 11) | 20) & 0xFu; }
#define XB_SPIN(cond, bar) do { unsigned _sp = 0; while (cond) { __builtin_amdgcn_s_sleep(1); \
    if ((++_sp & 255u) == 0u) { if (xb_ld(&(bar)[XB_TMO])) break; if (_sp > XB_SPIN_CAP) { atomicAdd(&(bar)[XB_TMO], 1u); break; } } } } while (0)

struct XcdBarrier {
    unsigned* bar; unsigned x;
    volatile LAS unsigned* st;
};

__device__ __forceinline__ XcdBarrier xcd_barrier_post(unsigned* bar, volatile LAS unsigned* st) {
    XcdBarrier b; b.bar = bar; b.x = xb_xcc_id(); b.st = st;
    if (threadIdx.x == 0) (void)xb_add(&bar[XB_XCNT(b.x)], 1u);
    return b;
}
__device__ __forceinline__ void xcd_barrier_complete(unsigned* bar, unsigned x, unsigned& nloc, unsigned& nx) {
    const unsigned G = gridDim.x * gridDim.y * gridDim.z;
    unsigned sum, cnt, mine, sp = 0u;
    for (;;) {
        sum = 0u; cnt = 0u; mine = 0u;
#pragma unroll
        for (unsigned j = 0; j < 16; ++j) { const unsigned c = xb_ld(&bar[XB_XCNT(j)]); sum += c; cnt += (c > 0u) ? 1u : 0u; mine = (j == x) ? c : mine; }
        if (sum == G) break;
        __builtin_amdgcn_s_sleep(1);
        if ((++sp & 255u) == 0u) { if (xb_ld(&bar[XB_TMO])) break; if (sp > XB_SPIN_CAP) { atomicAdd(&bar[XB_TMO], 1u); break; } }
    }
    nloc = mine > 0u ? mine : 1u; nx = cnt > 0u ? cnt : 1u;
}

__device__ __forceinline__ void xcd_barrier(const XcdBarrier& b) {
    asm volatile("s_waitcnt vmcnt(0)" ::: "memory");
    __syncthreads();
    if (threadIdx.x == 0) {
        unsigned* bar = b.bar;
        __builtin_amdgcn_s_waitcnt(0);
        unsigned nloc = b.st[0], nx = b.st[1];
        if (nloc == 0u) { xcd_barrier_complete(bar, b.x, nloc, nx); b.st[0] = nloc; b.st[1] = nx; }
        const unsigned old = xb_add(&bar[XB_XSUB(b.x)], 1u);
        const unsigned gen = old / nloc;
        if (old + 1u == (gen + 1u) * nloc) {
            __builtin_amdgcn_fence(__ATOMIC_RELEASE, "agent");
            asm volatile("s_waitcnt vmcnt(0)" ::: "memory");
            const unsigned og = xb_add(&bar[XB_TOP], 1u);
            const unsigned tg = og / nx;
            if (og + 1u == (tg + 1u) * nx) xb_add(&bar[XB_TOPGEN], 1u);
            else XB_SPIN(xb_ld(&bar[XB_TOPGEN]) == tg, bar);
            __builtin_amdgcn_fence(__ATOMIC_ACQUIRE, "agent");
            xb_add(&bar[XB_XGEN(b.x)], 1u);
            asm volatile("s_waitcnt vmcnt(0)" ::: "memory");
        } else {
            XB_SPIN(xb_ld(&bar[XB_XGEN(b.x)]) == gen, bar);
            __builtin_amdgcn_fence(__ATOMIC_ACQUIRE, "agent");
            asm volatile("s_waitcnt vmcnt(0)" ::: "memory");
        }
    }
    __syncthreads();
}

constexpr int CW_BAR = 1024;
constexpr int LDS_BARST = LDS_BYTES - 64;
#define LAYER_BODY(g, l) do { \
      { PHASE_BEGIN(); \
        const float* xin = (l == 0) ? a.x + (size_t)g * MG * DM : a.out + (size_t)g * MG * DM; \
        for (int rep = 0; rep < 1 + REP_MISC + REP_N; ++rep) phase_rows(xin, xb, rstd, MG, gw, ngw, lane); \
        if (l == 0 && g > 0) phase_final_norm(a.out + (size_t)(g - 1) * MG * DM, a.final_g, MG, gw, ngw, lane); \
      } \
      xcd_barrier(xbar); if (REP_SYNC) xcd_barrier(xbar); \
      { PHASE_BEGIN(); \
        pg8::Gemm gm{xb, (const bf16_t*)(ws + WS_WIN) + (size_t)l * NTOT * DM, MG, NTOT, DM}; \
        pg8::StaticOrder S; S.init(MG, NTOT, G, (int)blockIdx.x); \
        EpiA E{proj, gates}; \
        for (int rep = 0; rep < 1 + REP_A; ++rep) { pg8::gemm_phase<EpiA, pg8::StaticOrder, true, true>(lds, gm, S, E); __syncthreads(); } \
        if (REP_A1) { pg8::Gemm gm1{xb, (const bf16_t*)(ws + WS_WIN) + (size_t)l * NTOT * DM, MG, NP, DM}; pg8::StaticOrder S1; S1.init(MG, NP, G, (int)blockIdx.x); pg8::gemm_phase<EpiA, pg8::StaticOrder, true, true>(lds, gm1, S1, E); __syncthreads(); } \
      } \
      xcd_barrier(xbar); if (REP_SYNC) xcd_barrier(xbar); \
      { PHASE_BEGIN(); \
        b1_rope(proj, tab, gt, ngt); \
      } { PHASE_BEGIN(); \
        for (int rep = 0; rep < 1 + REP_B23 + REP_BALL; ++rep) { b2_vtrans(proj, vt, lds, gw, ngw, wid, lane); \
        b3_foxcum(proj, a.fox_f_bias + l * 4, c2, lds, tid, wid, lane); b7_knorm(proj, rstd, gw, ngw, lane); } \
        __syncthreads(); \
      } { PHASE_BEGIN(); \
        for (int rep = 0; rep < 1 + REP_MISC + REP_B4 + REP_BALL; ++rep) b4_compress(proj, (const bf16_t*)(ws + WS_W1T) + (size_t)l * 2 * 128 * 2048, (const bf16_t*)(ws + WS_W2T) + (size_t)l * 2 * 64 * 128, \
                    (const float*)(ws + WS_B1P) + l * 256, a.cmp_b2 + l * 128, tab, kc, vcT, lds, tid, wid, lane); \
        __syncthreads(); \
      } { PHASE_BEGIN(); \
        for (int rep = 0; rep < 1 + REP_B5 + REP_BALL; ++rep) b5_pool_mfma(proj, (const bf16_t*)(ws + WS_PWT) + (size_t)l * 4 * 4096, a.pool_scale + l * 256, ab + (size_t)1 * MG * 256, wid, lane); \
      } { PHASE_BEGIN(); \
        for (int rep = 0; rep < 1 + REP_MISC + REP_BALL; ++rep) b6_conv(proj, a.conv_w + l * 768, ab + (size_t)2 * MG * 256, gt, ngt); \
      } \
      xcd_barrier(xbar); if (REP_SYNC) xcd_barrier(xbar); \
      { PHASE_BEGIN(); \
        for (int rep = 0; rep < 1 + REP_C; ++rep) { \
        unsigned* ctr = (unsigned*)(ws + WS_CTL) + (g * DEPTH + l) + 8 * rep; \
        LAS unsigned* uw = (LAS unsigned*)(lds + AL_U); \
        constexpr int NUNITS = 16 * 8 * GB; \
        for (;;) { \
          if (tid == 0) uw[0] = atomicAdd(ctr, 1u); \
          __syncthreads(); \
          const unsigned u = uw[0]; \
          __syncthreads(); \
          if (u >= (unsigned)NUNITS) break; \
          if (u < (unsigned)(64 * GB)) nsa_unit((int)u % GB, 63 - (int)u / GB, proj, vt, kc, vcT, ab, lds, tid, wid, lane); \
          else { const int v = (int)u - 64 * GB, r = v % (4 * GB); fox_unit(r >> 2, r & 3, 15 - v / (4 * GB), proj, vt, c2, rstd, ab + (size_t)3 * MG * 256, lds, tid, wid, lane); } \
        } \
        __syncthreads(); } \
      } \
      xcd_barrier(xbar); if (REP_SYNC) xcd_barrier(xbar); \
      { PHASE_BEGIN(); \
        for (int rep = 0; rep < 1 + REP_D1; ++rep) d1_phase(ab, (const bf16_t*)(ws + WS_WBT) + (size_t)l * 4 * 1024 * 256, gates, tot, lds, tid, wid, lane); \
      } \
      xcd_barrier(xbar); if (REP_SYNC) xcd_barrier(xbar); \
      { PHASE_BEGIN(); \
        const float* xin = (l == 0) ? a.x + (size_t)g * MG * DM : a.out + (size_t)g * MG * DM; \
        pg8::Gemm gm{tot, (const bf16_t*)(ws + WS_WOT) + (size_t)l * 1024 * 1024, MG, DM, DM}; \
        pg8::StaticOrder S; S.init(MG, DM, G, (int)blockIdx.x); \
        EpiD2 E{xin, a.out + (size_t)g * MG * DM}; \
        for (int rep = 0; rep < 1 + ((l == 0) ? 2 * REP_D2 : 0); ++rep) { pg8::gemm_phase<EpiD2, pg8::StaticOrder, true, true>(lds, gm, S, E); __syncthreads(); } \
      } \
      xcd_barrier(xbar); if (REP_SYNC) xcd_barrier(xbar); \
 \
  } while (0)
__global__ void __launch_bounds__(512, 2) hybrid_fwd(Args a) {
  extern __shared__ __attribute__((aligned(16))) unsigned char lds_raw[];
  LAS unsigned char* lds = (LAS unsigned char*)lds_raw;
  cg::grid_group grid = cg::this_grid();
  const int tid0 = threadIdx.x;
  const int G = gridDim.x;
  const int ngt = G * 512, ngw = G * 8;
#define PHASE_BEGIN() int tid = tid0; asm volatile("" : "+v"(tid)); const int lane = tid & 63, wid = __builtin_amdgcn_readfirstlane(tid >> 6); \
      const int gt = blockIdx.x * 512 + tid, gw = blockIdx.x * 8 + wid; (void)lane; (void)wid; (void)gt; (void)gw; \
      __attribute__((address_space(1))) unsigned char* wsl_ = (__attribute__((address_space(1))) unsigned char*)a.ws; asm volatile("" : "+s"(wsl_)); unsigned char* ws = (unsigned char*)wsl_; \
      float* rstd = (float*)(ws + WS_RSTD); float* c2 = (float*)(ws + WS_CFOX); const float* tab = (const float*)(ws + WS_TAB); \
      bf16_t* kc = (bf16_t*)(ws + WS_KC); bf16_t* vcT = (bf16_t*)(ws + WS_VCT); bf16_t* vt = (bf16_t*)(ws + WS_VT); \
      bf16_t* xb = (bf16_t*)(ws + WS_XB); bf16_t* ab = (bf16_t*)(ws + WS_AB); bf16_t* tot = (bf16_t*)(ws + WS_TOT); \
      bf16_t* proj = (bf16_t*)(ws + WS_PROJ); unsigned char* gates = (unsigned char*)(ws + WS_GATES); \
      (void)rstd; (void)c2; (void)tab; (void)kc; (void)vcT; (void)vt; (void)xb; (void)ab; (void)tot; (void)proj; (void)gates;

  if (tid0 < 16) ((LAS unsigned*)(lds + LDS_BARST))[tid0] = 0u;
  __syncthreads();
  XcdBarrier xbar = xcd_barrier_post((unsigned*)(a.ws + WS_CTL) + CW_BAR, (volatile LAS unsigned*)(lds + LDS_BARST));
  for (int rep = 0; rep < 1 + REP_P0; ++rep) { const int gt = blockIdx.x * 512 + tid0; p0_prologue(a, gt, ngt); }
  grid.sync();

  LAYER_BODY(0, 0); LAYER_BODY(0, 1);
#if NGROUP > 1
  LAYER_BODY(1, 0); LAYER_BODY(1, 1);
#endif
#if NGROUP > 2
  LAYER_BODY(2, 0); LAYER_BODY(2, 1); LAYER_BODY(3, 0); LAYER_BODY(3, 1);
#endif
  { const int lane = tid0 & 63, gw = blockIdx.x * 8 + (tid0 >> 6); phase_final_norm(a.out + (size_t)(NG - 1) * MG * DM, a.final_g, MG, gw, ngw, lane); }
}

extern "C" void kernel_launch(void* const* d_in, const int* in_sizes, int n_in, void* d_out, int out_size, void* d_ws, size_t ws_size, hipStream_t stream) {
  static int grid = 0;
  if (!grid) {
    int dev = 0, cus = 0, per = 0;
    (void)hipGetDevice(&dev); (void)hipDeviceGetAttribute(&cus, hipDeviceAttributeMultiprocessorCount, dev);
    (void)hipFuncSetAttribute((const void*)hybrid_fwd, hipFuncAttributeMaxDynamicSharedMemorySize, LDS_BYTES);
    (void)hipOccupancyMaxActiveBlocksPerMultiprocessor(&per, (const void*)hybrid_fwd, 512, LDS_BYTES);
    if (per < 1) per = 1;
    grid = cus * per;
    if (ws_size < WS_END) fprintf(stderr, "workspace too small: %zu < %zu\n", ws_size, (size_t)WS_END);
  }
  (void)hipMemsetAsync((char*)d_ws + WS_CTL, 0, 18 * 1024, stream);
  Args a{};
  a.x = (const float*)d_in[0]; a.norm_g = (const float*)d_in[1]; a.w_in = (const float*)d_in[2]; a.fox_f_bias = (const float*)d_in[3];
  a.cmp_pos = (const float*)d_in[4]; a.cmp_w1 = (const float*)d_in[5]; a.cmp_b1 = (const float*)d_in[6]; a.cmp_w2 = (const float*)d_in[7];
  a.cmp_b2 = (const float*)d_in[8]; a.pool_w = (const float*)d_in[9]; a.pool_scale = (const float*)d_in[10]; a.conv_w = (const float*)d_in[11];
  a.w_branch = (const float*)d_in[12]; a.w_out = (const float*)d_in[13]; a.final_g = (const float*)d_in[14];
  a.out = (float*)d_out; a.ws = (unsigned char*)d_ws;
  void* args[] = {&a};
  hipError_t e = hipLaunchCooperativeKernel((const void*)hybrid_fwd, dim3(grid), dim3(512), args, LDS_BYTES, stream);
  if (e != hipSuccess) fprintf(stderr, "cooperative launch failed: %s (grid %d)\n", hipGetErrorString(e), grid);
}
```
